# Optimizing an MI355X kernel written in HIP

```python
import jax, jax.numpy as jnp
from jax import lax
import numpy as np

D_MODEL = 2048
BATCH = 1
SEQ = 8192
DEPTH = 2
DEC_BATCH = 8
DEC_SEQ = 32
PAST_LEN = 4096

CHUNK = 64
Q_BLOCK = 128
HEAD_DIM = 128
MIX_DIM = D_MODEL
CONV_DIM = MIX_DIM // 4
CONV_W = 3
SB_HEADS = (MIX_DIM - CONV_DIM) // (2 * HEAD_DIM)
FOX_HEADS = SB_HEADS
SB_DIM = SB_HEADS * HEAD_DIM
FOX_DIM = FOX_HEADS * HEAD_DIM
IN_DIM = 3 * CONV_DIM + 3 * SB_DIM + 3 * FOX_DIM + FOX_HEADS
D_FF = ((8 * D_MODEL + 3 * 256 - 1) // (3 * 256)) * 256
NORM_EPS = 1e-5

kernel_name = 'hybrid_stream_conv_stickbreak_fox_step'


def _rmsnorm(x, g):
    xf = x.astype(jnp.float32)
    xf = xf * lax.rsqrt(jnp.mean(xf * xf, axis=-1, keepdims=True) + NORM_EPS)
    return (xf * g.astype(jnp.float32)).astype(x.dtype)


def _split_points():
    c, s, f = CONV_DIM, SB_DIM, FOX_DIM
    return [c, 2 * c, 3 * c, 3 * c + s, 3 * c + 2 * s, 3 * c + 3 * s,
            3 * c + 3 * s + f, 3 * c + 3 * s + 2 * f, 3 * c + 3 * s + 3 * f]


def _stick_breaking(q, k, v, q_pos, k_pos):
    z = jnp.einsum('bqhd,bkhd->bhqk', q, k).astype(jnp.float32) * (HEAD_DIM ** -0.5)
    mask = k_pos[None, :] < q_pos[:, None]
    log_1m = jnp.where(mask, jax.nn.log_sigmoid(-z), 0.0)
    later = lax.cumsum(log_1m, axis=3, reverse=True) - log_1m
    w = jnp.where(mask, jnp.exp(jax.nn.log_sigmoid(z) + later), 0.0)
    return jnp.einsum('bhqk,bkhd->bqhd', w.astype(v.dtype), v)


def _forgetting(q, k, v, cq, ck, q_pos, k_pos):
    s = jnp.einsum('bqhd,bkhd->bhqk', q, k).astype(jnp.float32) * (HEAD_DIM ** -0.5)
    s = s + jnp.transpose(cq, (0, 2, 1))[..., :, None] - jnp.transpose(ck, (0, 2, 1))[..., None, :]
    mask = k_pos[None, :] <= q_pos[:, None]
    p = jax.nn.softmax(jnp.where(mask, s, -jnp.inf), axis=-1)
    return jnp.einsum('bhqk,bkhd->bqhd', p.astype(v.dtype), v)


def _query_blocks(attn, q_side, q_pos):
    n_blk = q_pos.shape[0] // Q_BLOCK
    def split(a):
        return jnp.moveaxis(a.reshape(a.shape[0], n_blk, Q_BLOCK, *a.shape[2:]), 1, 0)
    blocks = tuple(split(a) for a in q_side)
    out = lax.map(lambda xs: attn(*xs[0], xs[1]), (blocks, q_pos.reshape(n_blk, Q_BLOCK)))
    out = jnp.moveaxis(out, 0, 1)
    return out.reshape(out.shape[0], n_blk * Q_BLOCK, *out.shape[3:])


def _mixer(h, w_in, b_f, conv_w, conv_past, sbk_past, sbv_past, fk_past, fv_past, flogf_past, blocked):
    bsz, t_len, _ = h.shape
    past = sbk_past.shape[1]
    proj = h @ w_in
    g_b, g_c, hc, sq, sk, sv, fq, fk, fv, f_logit = jnp.split(proj, _split_points(), axis=-1)

    u = g_c * hc
    u_full = jnp.concatenate([conv_past.astype(u.dtype), u], axis=1)
    conv = conv_w[0] * u_full[:, 0:t_len]
    for i in range(1, CONV_W):
        conv = conv + conv_w[i] * u_full[:, i:i + t_len]
    y_a = g_b * conv
    new_conv = u_full[:, t_len:]

    heads = lambda a: a.reshape(bsz, t_len, -1, HEAD_DIM)
    sq, sk, sv, fq, fk, fv = heads(sq), heads(sk), heads(sv), heads(fq), heads(fk), heads(fv)
    q_pos = past + jnp.arange(t_len)
    k_pos = jnp.arange(past + t_len)
    sk_all = jnp.concatenate([sbk_past.astype(sk.dtype), sk], axis=1)
    sv_all = jnp.concatenate([sbv_past.astype(sv.dtype), sv], axis=1)
    fk_all = jnp.concatenate([fk_past.astype(fk.dtype), fk], axis=1)
    fv_all = jnp.concatenate([fv_past.astype(fv.dtype), fv], axis=1)

    logf = jax.nn.log_sigmoid(f_logit.astype(jnp.float32) + b_f.astype(jnp.float32))
    ck = jnp.cumsum(jnp.concatenate([flogf_past.astype(jnp.float32), logf], axis=1), axis=1)
    cq = ck[:, past:]

    sb_fn = lambda qb, qp: _stick_breaking(qb, sk_all, sv_all, qp, k_pos)
    fox_fn = lambda qb, cqb, qp: _forgetting(qb, fk_all, fv_all, cqb, ck, qp, k_pos)
    if blocked:
        y_sb = _query_blocks(sb_fn, (sq,), q_pos)
        y_fox = _query_blocks(fox_fn, (fq, cq), q_pos)
    else:
        y_sb = sb_fn(sq, q_pos)
        y_fox = fox_fn(fq, cq, q_pos)

    y = jnp.concatenate([y_a, y_sb.reshape(bsz, t_len, SB_DIM), y_fox.reshape(bsz, t_len, FOX_DIM)], axis=-1)
    return y, (new_conv, sk, sv, fk, fv, logf)


def _layer(x, norm1_g, w_in, b_f, conv_w, w_out, norm2_g, w_gate, w_up, w_down, past, blocked):
    y, new = _mixer(_rmsnorm(x, norm1_g), w_in, b_f, conv_w, *past, blocked)
    x = x + y @ w_out
    h = _rmsnorm(x, norm2_g)
    x = x + (jax.nn.silu(h @ w_gate) * (h @ w_up)) @ w_down
    return x, new


def setup_inputs(seed: int = 0) -> dict:
    key = jax.random.key(seed)
    ks = jax.random.split(key, 20)
    nrm = lambda k, shape, scale=1.0: scale * jax.random.normal(k, shape, jnp.float32)
    return {
        'x_prompt': nrm(ks[0], (BATCH, SEQ, D_MODEL)),
        'x_sample': nrm(ks[1], (DEC_BATCH, DEC_SEQ, D_MODEL)),
        'state_conv': nrm(ks[2], (DEPTH, DEC_BATCH, CONV_W - 1, CONV_DIM)),
        'cache_sb_k': nrm(ks[3], (DEPTH, DEC_BATCH, PAST_LEN, SB_HEADS, HEAD_DIM)),
        'cache_sb_v': nrm(ks[4], (DEPTH, DEC_BATCH, PAST_LEN, SB_HEADS, HEAD_DIM)),
        'cache_fox_k': nrm(ks[5], (DEPTH, DEC_BATCH, PAST_LEN, FOX_HEADS, HEAD_DIM)),
        'cache_fox_v': nrm(ks[6], (DEPTH, DEC_BATCH, PAST_LEN, FOX_HEADS, HEAD_DIM)),
        'cache_fox_logf': jax.nn.log_sigmoid(nrm(ks[7], (DEPTH, DEC_BATCH, PAST_LEN, FOX_HEADS))),
        'norm1_g': 1.0 + nrm(ks[8], (DEPTH, D_MODEL), 0.01),
        'w_in': nrm(ks[9], (DEPTH, D_MODEL, IN_DIM), D_MODEL ** -0.5),
        'b_f': nrm(ks[10], (DEPTH, FOX_HEADS), 0.1),
        'conv_w': nrm(ks[11], (DEPTH, CONV_W, CONV_DIM), CONV_W ** -0.5),
        'w_out': nrm(ks[12], (DEPTH, MIX_DIM, D_MODEL), MIX_DIM ** -0.5),
        'norm2_g': 1.0 + nrm(ks[13], (DEPTH, D_MODEL), 0.01),
        'w_gate': nrm(ks[14], (DEPTH, D_MODEL, D_FF), D_MODEL ** -0.5),
        'w_up': nrm(ks[15], (DEPTH, D_MODEL, D_FF), D_MODEL ** -0.5),
        'w_down': nrm(ks[16], (DEPTH, D_FF, D_MODEL), D_FF ** -0.5),
        'final_g': 1.0 + nrm(ks[17], (D_MODEL,), 0.01),
    }


def reference(x_prompt, x_sample, state_conv, cache_sb_k, cache_sb_v, cache_fox_k, cache_fox_v,
              cache_fox_logf, norm1_g, w_in, b_f, conv_w, w_out, norm2_g, w_gate, w_up, w_down, final_g):
    dt = x_prompt.dtype
    bp = x_prompt.shape[0]
    p_past = (jnp.zeros((bp, CONV_W - 1, CONV_DIM), dt),
              jnp.zeros((bp, 0, SB_HEADS, HEAD_DIM), dt), jnp.zeros((bp, 0, SB_HEADS, HEAD_DIM), dt),
              jnp.zeros((bp, 0, FOX_HEADS, HEAD_DIM), dt), jnp.zeros((bp, 0, FOX_HEADS, HEAD_DIM), dt),
              jnp.zeros((bp, 0, FOX_HEADS), jnp.float32))
    xp, xs = x_prompt, x_sample
    p_new, s_new = [], []
    for l in range(DEPTH):
        w = (norm1_g[l], w_in[l], b_f[l], conv_w[l], w_out[l], norm2_g[l], w_gate[l], w_up[l], w_down[l])
        xp, pn = _layer(xp, *w, p_past, True)
        s_past = (state_conv[l], cache_sb_k[l], cache_sb_v[l], cache_fox_k[l], cache_fox_v[l], cache_fox_logf[l])
        xs, sn = _layer(xs, *w, s_past, False)
        p_new.append(pn)
        s_new.append(sn)
    stack = lambda news, i: jnp.stack([n[i] for n in news])
    y_prompt = _rmsnorm(xp, final_g)
    y_sample = _rmsnorm(xs, final_g)
    return (y_prompt, y_sample,
            stack(p_new, 0), stack(p_new, 1), stack(p_new, 2), stack(p_new, 3), stack(p_new, 4), stack(p_new, 5),
            stack(s_new, 0), stack(s_new, 1), stack(s_new, 2), stack(s_new, 3), stack(s_new, 4), stack(s_new, 5))
```

```cpp
#include <hip/hip_runtime.h>
#include <cstdio>
#include <cstdint>
#include <cmath>

#define LAS __attribute__((address_space(3)))
#define GAS __attribute__((address_space(1)))
typedef unsigned short bf16_t;
typedef short bf16x8 __attribute__((ext_vector_type(8)));
typedef short s16x4 __attribute__((ext_vector_type(4)));
typedef float f32x2 __attribute__((ext_vector_type(2)));
typedef float f32x4 __attribute__((ext_vector_type(4)));
typedef float f32x16 __attribute__((ext_vector_type(16)));
typedef unsigned u32x2 __attribute__((ext_vector_type(2)));
typedef unsigned u32x4 __attribute__((ext_vector_type(4)));
typedef GAS unsigned gu32;

constexpr int DM = 2048, SEQ = 8192, NSMP = 256, MT = SEQ + NSMP  ;
constexpr int NPROJ = 6144, IN_DIM = 6150, DFF = 5632, NGU = 2 * DFF, PAST = 4096, DSEQ = 32, DB = 8, NH = 6, HD = 128, CONVD = 512;
constexpr int C_GB = 0, C_GC = 512, C_HC = 1024, C_SQ = 1536, C_SK = 2304, C_SV = 3072, C_FQ = 3840, C_FK = 4608, C_FV = 5376;
constexpr float EPS = 1e-5f, LOG2E = 1.4426950408889634f, LN2 = 0.6931471805599453f, QK_SCALE = 0.08838834764831845f;
constexpr float EXIT_T = 40.f;
constexpr size_t O_YP = 0, O_YS = 16777216, O_PCONV = 17301504, O_PSBK = 17303552, O_PSBV = 29886464, O_PFK = 42469376, O_PFV = 55052288, O_PLOGF = 67635200,
                 O_SCONV = 67733504, O_SSBK = 67749888, O_SSBV = 68143104, O_SFK = 68536320, O_SFV = 68929536, O_SLOGF = 69322752, O_TOTAL = 69325824;
constexpr size_t P_KV_STRIDE = (size_t)2 * SEQ * 768, S_KV_STRIDE = (size_t)2 * NSMP * 768;
constexpr size_t MiB = 1u << 20;
constexpr size_t WS_CTL = 0, CTL_ZERO_BYTES = 1 * MiB, WS_WF = 1 * MiB, WS_WIN = 2 * MiB, WS_WOUT = 50 * MiB, WS_WGU = 66 * MiB, WS_WDN = 154 * MiB,
                 WS_XB = 198 * MiB, WS_XF = 231 * MiB, WS_PROJ = 297 * MiB, WS_Y = 396 * MiB, WS_H = 429 * MiB, WS_END = 520 * MiB;
constexpr size_t WIN_L = (size_t)NPROJ * DM, WOUT_L = (size_t)DM * DM, WGU_L = (size_t)NGU * DM, WDN_L = (size_t)DM * DFF;
constexpr int CW_BAR = 4096, CW_Q = 8192, CW_KMAXP = 8192 + 256, CW_KMAXS = 8192 + 512, CW_KMAXC = 8192 + 1024, CW_SSQ = 16384;
constexpr int RING_BYTES = 131072, MISC_OFF = RING_BYTES + 320, LDS_BYTES = 147456;

typedef __bf16 bf16x2_t __attribute__((ext_vector_type(2)));
__device__ __forceinline__ unsigned cvt_pk_bf16(float lo, float hi) { const f32x2 v = {lo, hi}; const bf16x2_t b = __builtin_convertvector(v, bf16x2_t); return __builtin_bit_cast(unsigned, b); }
__device__ __forceinline__ float bf_lo(unsigned w) { return __uint_as_float(w << 16); }
__device__ __forceinline__ float bf_hi(unsigned w) { return __uint_as_float(w & 0xffff0000u); }
template <int CTRL> __device__ __forceinline__ float dpp_mov(float v) { return __int_as_float(__builtin_amdgcn_update_dpp(0, __float_as_int(v), CTRL, 0xF, 0xF, true)); }
__device__ __forceinline__ float row16_sum(float v) { v += dpp_mov<0xB1>(v); v += dpp_mov<0x4E>(v); v += dpp_mov<0x141>(v); v += dpp_mov<0x140>(v); return v; }
__device__ __forceinline__ float row16_max(float v) { v = fmaxf(v, dpp_mov<0xB1>(v)); v = fmaxf(v, dpp_mov<0x4E>(v)); v = fmaxf(v, dpp_mov<0x141>(v)); v = fmaxf(v, dpp_mov<0x140>(v)); return v; }
__device__ __forceinline__ float swap16_sum(float v) { auto rr = __builtin_amdgcn_permlane16_swap(__float_as_uint(v), __float_as_uint(v), false, false); return __uint_as_float(rr[0]) + __uint_as_float(rr[1]); }
__device__ __forceinline__ float swap32_sum(float v) { auto rr = __builtin_amdgcn_permlane32_swap(__float_as_uint(v), __float_as_uint(v), false, false); return __uint_as_float(rr[0]) + __uint_as_float(rr[1]); }
__device__ __forceinline__ float swap32_max(float v) { auto rr = __builtin_amdgcn_permlane32_swap(__float_as_uint(v), __float_as_uint(v), false, false); return fmaxf(__uint_as_float(rr[0]), __uint_as_float(rr[1])); }
__device__ __forceinline__ float wave_sum(float v) { return swap32_sum(swap16_sum(row16_sum(v))); }
__device__ __forceinline__ float bperm(int src_lane, float v) { return __int_as_float(__builtin_amdgcn_ds_bpermute(src_lane << 2, __float_as_int(v))); }
__device__ __forceinline__ float ex2(float x) { return __builtin_amdgcn_exp2f(x); }
__device__ __forceinline__ float lg2(float x) { return __builtin_amdgcn_logf(x); }
__device__ __forceinline__ float partner32(float v, int hi) {
    auto rr = __builtin_amdgcn_permlane32_swap(__float_as_uint(v), __float_as_uint(v), false, false);
    return __uint_as_float(hi ? rr[0] : rr[1]);
}
#define LDS_WAIT() asm volatile("s_waitcnt lgkmcnt(0)" ::: "memory")
#define VM_WAIT() asm volatile("s_waitcnt vmcnt(0)" ::: "memory")

namespace pg8 {
constexpr int BM = 256, BK = 64, HALF = 128, HTB = HALF * BK * 2, STAGE_BYTES = 8 * HTB, NXCD = 8, WGM = 8;
__host__ __device__ __forceinline__ int lds_byte(int r, int c) { const int st = (r >> 4) * 2 + (c >> 5), rr = r & 15, cc = c & 31, ob = rr * 64 + cc * 2; return st * 1024 + (ob ^ (((ob >> 9) & 1) << 5)); }
__host__ __device__ __forceinline__ void stage_rc(int b, int& R, int& C) { const int st = b / 1024, sb = b % 1024, swz = sb ^ (((sb >> 9) & 1) << 5); R = (st >> 1) * 16 + swz / 64; C = (st & 1) * 32 + (swz % 64) / 2; }
__host__ __device__ __forceinline__ int perm32(int rho) { const int n = rho >> 4, i = rho & 15; return 8 * (i >> 2) + 4 * n + (i & 3); }
struct Unit { int pm, pn; };
struct Gemm { const bf16_t* A; const bf16_t* Bt; int M, N, K; };
struct StaticOrder {
    int nM, nN, nwg, G, c;
    __host__ __device__ void init(int M, int N, int G_, int c_) { nM = M / BM; nN = N / BM; nwg = nM * nN; G = G_; c = c_; }
    __host__ __device__ bool next(int i, Unit& u) const {
        const long L = (long)i * G + c; if (L >= nwg) return false;
        int wgid = (int)L; { const int q = nwg / NXCD, r = nwg % NXCD, xcd = wgid % NXCD, off = wgid / NXCD; wgid = (xcd < r ? xcd * (q + 1) : r * (q + 1) + (xcd - r) * q) + off; }
        const int nig = WGM * nN, gid = wgid / nig, fm = gid * WGM, gsz = (nM - fm) < WGM ? (nM - fm) : WGM;
        u.pm = fm + ((wgid % nig) % gsz); u.pn = (wgid % nig) / gsz; return true;
    }
    __device__ __forceinline__ void a_ready(const Unit&) const {}
    __device__ __forceinline__ void done(const Unit&) const {}
};


struct EpiProj {
    static constexpr bool PERM = true, AFTER_DRAIN = false;
    bf16_t* proj; const float* ssq; float* out; int layer; unsigned* kmaxp; unsigned* kmaxs;
    __device__ __forceinline__ void operator()(const f32x4 (&acc)[2][2][4][2], const Unit& u, int wr, int wc, int fr, int fq) const {
        const int row0 = u.pm * BM + wr * 64 + fr, col0 = u.pn * BM + wc * 32 + 8 * fq;
        int seg = -1, segcol = 0;
        if (u.pn >= 9 && u.pn < 15) { seg = (u.pn - 9) / 3; segcol = ((u.pn - 9) % 3) * 256; }
        else if (u.pn >= 18) { seg = 2 + (u.pn - 18) / 3; segcol = ((u.pn - 18) % 3) * 256; }
        const bool isfk = (u.pn >= 18 && u.pn < 21);
        float ssr[2][2][4];
#pragma unroll
        for (int ai = 0; ai < 2; ++ai)
#pragma unroll
            for (int m = 0; m < 4; ++m) {
                const int r = row0 + ai * HALF + m * 16;
                const float rs = rsqrtf(ssq[r] * (1.0f / DM) + EPS);
                bf16_t* rowp = proj + (size_t)r * NPROJ + col0;
                float* orow = nullptr;
                if (seg >= 0) orow = (r < SEQ) ? out + O_PSBK + (size_t)seg * P_KV_STRIDE + ((size_t)layer * SEQ + r) * 768 + segcol + wc * 32 + 8 * fq
                                               : out + O_SSBK + (size_t)seg * S_KV_STRIDE + ((size_t)layer * NSMP + (r - SEQ)) * 768 + segcol + wc * 32 + 8 * fq;
#pragma unroll
                for (int bj = 0; bj < 2; ++bj) {
                    const f32x4 v0 = acc[ai][bj][m][0] * rs, v1 = acc[ai][bj][m][1] * rs;
                    u32x4 w; w.x = cvt_pk_bf16(v0[0], v0[1]); w.y = cvt_pk_bf16(v0[2], v0[3]); w.z = cvt_pk_bf16(v1[0], v1[1]); w.w = cvt_pk_bf16(v1[2], v1[3]);
                    *(u32x4*)(rowp + bj * HALF) = w;
                    if (seg >= 0) { *(f32x4*)(orow + bj * HALF) = v0; *(f32x4*)(orow + bj * HALF + 4) = v1; }
                    float ss = (v0[0] * v0[0] + v0[1] * v0[1]) + (v0[2] * v0[2] + v0[3] * v0[3]) + (v1[0] * v1[0] + v1[1] * v1[1]) + (v1[2] * v1[2] + v1[3] * v1[3]);
                    ssr[bj][ai][m] = ss;
                }
            }
        if (isfk) {
#pragma unroll
            for (int bj = 0; bj < 2; ++bj) {
                const int head = 2 * (u.pn - 18) + bj;
                float pr[2][4];
#pragma unroll
                for (int ai = 0; ai < 2; ++ai)
#pragma unroll
                    for (int m = 0; m < 4; ++m) pr[ai][m] = swap32_sum(swap16_sum(ssr[bj][ai][m]));
                if (u.pm < SEQ / BM) {
                    float mx = fmaxf(fmaxf(fmaxf(pr[0][0], pr[0][1]), fmaxf(pr[0][2], pr[0][3])), fmaxf(fmaxf(pr[1][0], pr[1][1]), fmaxf(pr[1][2], pr[1][3])));
                    mx = row16_max(mx);
                    if (fr == 0 && fq == 0) atomicMax(kmaxp + (layer * NH + head) * 4 + wc, __float_as_uint(mx));
                } else {
#pragma unroll
                    for (int ai = 0; ai < 2; ++ai)
#pragma unroll
                        for (int mp = 0; mp < 2; ++mp) {
                            float mx = row16_max(fmaxf(pr[ai][2 * mp], pr[ai][2 * mp + 1]));
                            const int b = 4 * ai + 2 * wr + mp;
                            if (fr == 0 && fq == 0) atomicMax(kmaxs + ((layer * DB + b) * NH + head) * 4 + wc, __float_as_uint(mx));
                        }
                }
            }
        }
    }
};
struct EpiRes {
    static constexpr bool PERM = true, AFTER_DRAIN = false;
    const float* base_p; const float* base_s; float* xf; bf16_t* xb; float* ssq_out;
    __device__ __forceinline__ void operator()(const f32x4 (&acc)[2][2][4][2], const Unit& u, int wr, int wc, int fr, int fq) const {
        const int row0 = u.pm * BM + wr * 64 + fr, col0 = u.pn * BM + wc * 32 + 8 * fq;
#pragma unroll
        for (int ai = 0; ai < 2; ++ai)
#pragma unroll
            for (int m = 0; m < 4; ++m) {
                const int r = row0 + ai * HALF + m * 16;
                const float* bp = (r < SEQ) ? base_p + (size_t)r * DM + col0 : base_s + (size_t)(r - SEQ) * DM + col0;
                float* xo = xf + (size_t)r * DM + col0; bf16_t* bo = xb + (size_t)r * DM + col0;
                float ss = 0.f;
#pragma unroll
                for (int bj = 0; bj < 2; ++bj) {
                    const f32x4 v0 = *(const f32x4*)(bp + bj * HALF) + acc[ai][bj][m][0], v1 = *(const f32x4*)(bp + bj * HALF + 4) + acc[ai][bj][m][1];
                    *(f32x4*)(xo + bj * HALF) = v0; *(f32x4*)(xo + bj * HALF + 4) = v1;
                    u32x4 w; w.x = cvt_pk_bf16(v0[0], v0[1]); w.y = cvt_pk_bf16(v0[2], v0[3]); w.z = cvt_pk_bf16(v1[0], v1[1]); w.w = cvt_pk_bf16(v1[2], v1[3]);
                    *(u32x4*)(bo + bj * HALF) = w;
                    ss += (v0[0] * v0[0] + v0[1] * v0[1]) + (v0[2] * v0[2] + v0[3] * v0[3]) + (v1[0] * v1[0] + v1[1] * v1[1]) + (v1[2] * v1[2] + v1[3] * v1[3]);
                }
                ss = swap32_sum(swap16_sum(ss));
                if (fq == 0) atomicAdd(ssq_out + r, ss);
            }
    }
};
struct EpiGU {
    static constexpr bool PERM = true, AFTER_DRAIN = false;
    bf16_t* h; const float* ssq;
    __device__ __forceinline__ void operator()(const f32x4 (&acc)[2][2][4][2], const Unit& u, int wr, int wc, int fr, int fq) const {
        const int row0 = u.pm * BM + wr * 64 + fr, col0 = u.pn * HALF + wc * 32 + 8 * fq;
#pragma unroll
        for (int ai = 0; ai < 2; ++ai)
#pragma unroll
            for (int m = 0; m < 4; ++m) {
                const int r = row0 + ai * HALF + m * 16;
                const float rs = rsqrtf(ssq[r] * (1.0f / DM) + EPS);
                float o[8];
#pragma unroll
                for (int n = 0; n < 2; ++n)
#pragma unroll
                    for (int i = 0; i < 4; ++i) {
                        const float g = acc[ai][0][m][n][i] * rs, up = acc[ai][1][m][n][i] * rs;
                        o[4 * n + i] = g * up * __builtin_amdgcn_rcpf(1.0f + ex2(-g * LOG2E));
                    }
                u32x4 w; w.x = cvt_pk_bf16(o[0], o[1]); w.y = cvt_pk_bf16(o[2], o[3]); w.z = cvt_pk_bf16(o[4], o[5]); w.w = cvt_pk_bf16(o[6], o[7]);
                *(u32x4*)(h + (size_t)r * DFF + col0) = w;
            }
    }
};

template <class Epi, class Sched, bool ALIGN_EPI = false, bool SP2 = false>
__device__ __forceinline__ void gemm_phase(LAS unsigned char* lds, const Gemm g, const Sched& S, const Epi& E) {
    int tid = threadIdx.x; asm volatile("" : "+v"(tid));
    const int wid = __builtin_amdgcn_readfirstlane(tid >> 6), lane = tid & 63, wr = wid >> 2, wc = wid & 3, fr = lane & 15, fq = lane >> 4;
    const int K = g.K, nt = K / BK;
    unsigned voffA[2], voffB[2];
#pragma unroll
    for (int i = 0; i < 2; ++i) { int R, C; stage_rc(tid * 16 + i * 8192, R, C); const int Rb = Epi::PERM ? ((R & ~31) + perm32(R & 31)) : R;
        voffA[i] = (unsigned)(R * K + C) * 2u; voffB[i] = (unsigned)(Rb * K + C) * 2u; }
    const size_t kstep = (size_t)(BK * 2);
    const size_t hstep = (size_t)HALF * K * 2;
    const size_t tstep = 2 * hstep;
    const unsigned ldsw = (unsigned)wid * 1024u;
    const int aoff = lds_byte(wr * 64 + fr, fq * 8), boff = lds_byte(wc * 32 + fr, fq * 8);
#define PG8_SA(b, h) (((b) * 2 + (h)) * HTB)
#define PG8_SB(b, h) ((4 + (b) * 2 + (h)) * HTB)
#define PG8_STAGE(bufoff, gbase, voff) do { _Pragma("unroll") for (int _i = 0; _i < 2; ++_i) \
        __builtin_amdgcn_global_load_lds((const unsigned*)((const char*)(gbase) + (voff)[_i]), (LAS unsigned*)(lds + (bufoff) + ldsw + _i * 8192), 16, 0, 0); } while (0)
#define PG8_LDA(dst, b, h) do { _Pragma("unroll") for (int m = 0; m < 4; ++m) _Pragma("unroll") for (int k = 0; k < 2; ++k) dst[m][k] = *(const LAS bf16x8*)(lds + PG8_SA(b, h) + aoff + m * 2048 + k * 1024); } while (0)
#define PG8_LDB(dst, b, h) do { _Pragma("unroll") for (int n = 0; n < 2; ++n) _Pragma("unroll") for (int k = 0; k < 2; ++k) dst[n][k] = *(const LAS bf16x8*)(lds + PG8_SB(b, h) + boff + n * 2048 + k * 1024); } while (0)
#define PG8_MMA(ai, bj, At, Bt) do { __builtin_amdgcn_s_setprio(1); _Pragma("unroll") for (int m = 0; m < 4; ++m) _Pragma("unroll") for (int n = 0; n < 2; ++n) _Pragma("unroll") for (int k = 0; k < 2; ++k) \
        acc[ai][bj][m][n] = __builtin_amdgcn_mfma_f32_16x16x32_bf16(Bt[n][k], At[m][k], acc[ai][bj][m][n], 0, 0, 0); __builtin_amdgcn_s_setprio(0); } while (0)
#define PG8_WAIT_V(n) asm volatile("s_waitcnt vmcnt(" #n ")" ::: "memory")
#define PG8_WAIT_L(n) asm volatile("s_waitcnt lgkmcnt(" #n ")" ::: "memory")
#define PG8_BAR __builtin_amdgcn_s_barrier()
#define PG8_SCHED __builtin_amdgcn_sched_barrier(0)
    Unit cur, nxt; int ui = 0;
    if (!S.next(0, cur)) return;
    f32x4 acc[2][2][4][2];
#pragma unroll
    for (int a = 0; a < 2; ++a)
#pragma unroll
        for (int b = 0; b < 2; ++b)
#pragma unroll
            for (int m = 0; m < 4; ++m)
#pragma unroll
                for (int n = 0; n < 2; ++n) acc[a][b][m][n] = (f32x4){0.f, 0.f, 0.f, 0.f};
    bf16x8 At[4][2], B0[2][2], B1[2][2];
    const char* cA = (const char*)g.A + (size_t)cur.pm * tstep; const char* cB = (const char*)g.Bt + (size_t)cur.pn * tstep;
    S.a_ready(cur);
    if constexpr (SP2) {
        PG8_STAGE(PG8_SB(0, 0), cB, voffB); PG8_STAGE(PG8_SB(0, 1), cB + hstep, voffB); PG8_STAGE(PG8_SA(0, 0), cA, voffA); PG8_STAGE(PG8_SA(0, 1), cA + hstep, voffA);
        if (wr == 1) PG8_BAR;
        PG8_WAIT_V(2); PG8_BAR;
        PG8_STAGE(PG8_SB(1, 0), cB + kstep, voffB); PG8_STAGE(PG8_SA(1, 0), cA + kstep, voffA); PG8_STAGE(PG8_SB(1, 1), cB + hstep + kstep, voffB);
        PG8_WAIT_V(6); PG8_BAR;
    } else {
        PG8_STAGE(PG8_SB(0, 0), cB, voffB); PG8_STAGE(PG8_SA(0, 0), cA, voffA); PG8_STAGE(PG8_SB(0, 1), cB + hstep, voffB); PG8_STAGE(PG8_SA(0, 1), cA + hstep, voffA);
        if (wr == 1) PG8_BAR;
        PG8_WAIT_V(4); PG8_BAR;
        PG8_STAGE(PG8_SB(1, 0), cB + kstep, voffB); PG8_STAGE(PG8_SA(1, 0), cA + kstep, voffA); PG8_STAGE(PG8_SB(1, 1), cB + hstep + kstep, voffB);
        PG8_WAIT_V(6); PG8_BAR;
    }
    for (;;) {
        const bool has_next = S.next(ui + 1, nxt);
        const char* nA = has_next ? (const char*)g.A + (size_t)nxt.pm * tstep : cA; const char* nB = has_next ? (const char*)g.Bt + (size_t)nxt.pn * tstep : cB;
        for (int t = 0; t < nt; t += 2) {
            const bool last = (t == nt - 2);
            const char* a1 = cA + (size_t)(t + 1) * kstep;
            const char* a2 = last ? nA : cA + (size_t)(t + 2) * kstep; const char* b2 = last ? nB : cB + (size_t)(t + 2) * kstep;
            const char* a3 = a2 + kstep; const char* b3 = b2 + kstep;
            if (last && has_next) S.a_ready(nxt);
            if constexpr (SP2) {
            PG8_LDB(B0, 0, 0); PG8_LDB(B1, 0, 1); PG8_SCHED; PG8_LDA(At, 0, 0); PG8_STAGE(PG8_SA(1, 1), a1 + hstep, voffA);
            PG8_WAIT_V(8); PG8_WAIT_L(0); PG8_BAR; PG8_MMA(0, 0, At, B0); PG8_MMA(0, 1, At, B1); PG8_BAR; PG8_SCHED;
            PG8_LDA(At, 0, 1); PG8_STAGE(PG8_SB(0, 0), b2, voffB); PG8_STAGE(PG8_SB(0, 1), b2 + hstep, voffB); PG8_STAGE(PG8_SA(0, 0), a2, voffA);
            PG8_WAIT_V(8); PG8_WAIT_L(0); PG8_BAR; PG8_MMA(1, 0, At, B0); PG8_MMA(1, 1, At, B1); PG8_BAR; PG8_SCHED;
            PG8_LDB(B0, 1, 0); PG8_LDB(B1, 1, 1); PG8_SCHED; PG8_LDA(At, 1, 0); PG8_STAGE(PG8_SA(0, 1), a2 + hstep, voffA);
            PG8_WAIT_V(8); PG8_WAIT_L(0); PG8_BAR; PG8_MMA(0, 0, At, B0); PG8_MMA(0, 1, At, B1); PG8_BAR; PG8_SCHED;
            PG8_LDA(At, 1, 1); PG8_STAGE(PG8_SB(1, 0), b3, voffB); PG8_STAGE(PG8_SB(1, 1), b3 + hstep, voffB); PG8_STAGE(PG8_SA(1, 0), a3, voffA);
            PG8_WAIT_V(8); PG8_WAIT_L(0); PG8_BAR; PG8_MMA(1, 0, At, B0); PG8_MMA(1, 1, At, B1); PG8_BAR; PG8_SCHED;
            } else {
            PG8_LDB(B0, 0, 0); PG8_SCHED; PG8_LDA(At, 0, 0); PG8_STAGE(PG8_SA(1, 1), a1 + hstep, voffA);
            PG8_WAIT_L(8); PG8_BAR; PG8_WAIT_L(0); PG8_MMA(0, 0, At, B0); PG8_BAR; PG8_SCHED;
            PG8_LDB(B1, 0, 1); PG8_STAGE(PG8_SB(0, 0), b2, voffB);
            PG8_BAR; PG8_WAIT_L(0); PG8_MMA(0, 1, At, B1); PG8_BAR;
            PG8_LDA(At, 0, 1); PG8_STAGE(PG8_SA(0, 0), a2, voffA);
            PG8_BAR; PG8_WAIT_L(0); PG8_MMA(1, 0, At, B0); PG8_BAR; PG8_SCHED;
            PG8_STAGE(PG8_SB(0, 1), b2 + hstep, voffB);
            PG8_WAIT_V(6); PG8_BAR; PG8_MMA(1, 1, At, B1); PG8_BAR;
            PG8_LDB(B0, 1, 0); PG8_SCHED; PG8_LDA(At, 1, 0); PG8_STAGE(PG8_SA(0, 1), a2 + hstep, voffA);
            PG8_WAIT_L(8); PG8_BAR; PG8_WAIT_L(0); PG8_MMA(0, 0, At, B0); PG8_BAR; PG8_SCHED;
            PG8_LDB(B1, 1, 1); PG8_STAGE(PG8_SB(1, 0), b3, voffB);
            PG8_BAR; PG8_WAIT_L(0); PG8_MMA(0, 1, At, B1); PG8_BAR;
            PG8_LDA(At, 1, 1); PG8_STAGE(PG8_SA(1, 0), a3, voffA);
            PG8_BAR; PG8_WAIT_L(0); PG8_MMA(1, 0, At, B0); PG8_BAR; PG8_SCHED;
            PG8_STAGE(PG8_SB(1, 1), b3 + hstep, voffB);
            PG8_WAIT_V(6); PG8_BAR; PG8_MMA(1, 1, At, B1); PG8_BAR;
            }
        }
        if constexpr (ALIGN_EPI) { if (wr == 0) PG8_BAR; }
        if constexpr (!Epi::AFTER_DRAIN) { E(acc, cur, wr, wc, fr, fq); S.done(cur); }
        if (!has_next) break;
#pragma unroll
        for (int a = 0; a < 2; ++a)
#pragma unroll
            for (int b = 0; b < 2; ++b)
#pragma unroll
                for (int m = 0; m < 4; ++m)
#pragma unroll
                    for (int n = 0; n < 2; ++n) acc[a][b][m][n] = (f32x4){0.f, 0.f, 0.f, 0.f};
        cur = nxt; cA = nA; cB = nB; ++ui;
        if constexpr (ALIGN_EPI) { if (wr == 1) PG8_BAR; }
    }
    PG8_WAIT_V(0);
    if constexpr (!ALIGN_EPI) { if (wr == 0) PG8_BAR; }
    PG8_BAR;
#undef PG8_SA
#undef PG8_SB
#undef PG8_STAGE
#undef PG8_LDA
#undef PG8_LDB
#undef PG8_MMA
#undef PG8_WAIT_V
#undef PG8_WAIT_L
#undef PG8_BAR
#undef PG8_SCHED
}
}

#define XB_TMO      128
#define XB_XCNT(j)  (256  + 64 * (j))
#define XB_XSUB(j)  (1280 + 64 * (j))
#define XB_XGEN(j)  (2304 + 64 * (j))
#define XB_TOP      3328
#define XB_TOPGEN   3392
#define XCD_BAR_WORDS 3456
#define XB_SPIN_CAP (1u << 18)
__device__ __forceinline__ unsigned xb_ld(unsigned* p)              { return __hip_atomic_load(p, __ATOMIC_RELAXED, __HIP_MEMORY_SCOPE_AGENT); }
__device__ __forceinline__ unsigned xb_add(unsigned* p, unsigned v) { return __hip_atomic_fetch_add(p, v, __ATOMIC_RELAXED, __HIP_MEMORY_SCOPE_AGENT); }
__device__ __forceinline__ unsigned xb_xcc_id() { return (unsigned)__builtin_amdgcn_s_getreg((3 << 11) | 20) & 0xFu; }
#define XB_SPIN(cond, bar) do { unsigned _sp = 0; while (cond) { __builtin_amdgcn_s_sleep(1); \
    if ((++_sp & 255u) == 0u) { if (xb_ld(&(bar)[XB_TMO])) break; if (_sp > XB_SPIN_CAP) { atomicAdd(&(bar)[XB_TMO], 1u); break; } } } } while (0)
struct XcdBarrier { unsigned* bar; unsigned x; volatile LAS unsigned* st; };
__device__ __forceinline__ XcdBarrier xcd_barrier_post(unsigned* bar, volatile LAS unsigned* st) {
    XcdBarrier b; b.bar = bar; b.x = xb_xcc_id(); b.st = st;
    if (threadIdx.x == 0) (void)xb_add(&bar[XB_XCNT(b.x)], 1u);
    return b;
}
__device__ __forceinline__ void xcd_barrier_complete(unsigned* bar, unsigned x, unsigned& nloc, unsigned& nx) {
    const unsigned G = gridDim.x * gridDim.y * gridDim.z;
    unsigned sum, cnt, mine, sp = 0u;
    for (;;) {
        sum = 0u; cnt = 0u; mine = 0u;
#pragma unroll
        for (unsigned j = 0; j < 16; ++j) { const unsigned c = xb_ld(&bar[XB_XCNT(j)]); sum += c; cnt += (c > 0u) ? 1u : 0u; mine = (j == x) ? c : mine; }
        if (sum == G) break;
        __builtin_amdgcn_s_sleep(1);
        if ((++sp & 255u) == 0u) { if (xb_ld(&bar[XB_TMO])) break; if (sp > XB_SPIN_CAP) { atomicAdd(&bar[XB_TMO], 1u); break; } }
    }
    nloc = mine > 0u ? mine : 1u; nx = cnt > 0u ? cnt : 1u;
}
__device__ __forceinline__ void xcd_barrier(const XcdBarrier& b) {
    asm volatile("s_waitcnt vmcnt(0)" ::: "memory");
    __syncthreads();
    if (threadIdx.x == 0) {
        long zb_ = 0; asm volatile("" : "+s"(zb_)); unsigned* bar = b.bar + zb_;
        unsigned bx_ = b.x; asm volatile("" : "+s"(bx_));
        __builtin_amdgcn_s_waitcnt(0);
        unsigned nloc = b.st[0], nx = b.st[1];
        if (nloc == 0u) { xcd_barrier_complete(bar, bx_, nloc, nx); b.st[0] = nloc; b.st[1] = nx; }
        const unsigned old = xb_add(&bar[XB_XSUB(bx_)], 1u);
        const unsigned gen = old / nloc;
        if (old + 1u == (gen + 1u) * nloc) {
            __builtin_amdgcn_fence(__ATOMIC_RELEASE, "agent");
            asm volatile("s_waitcnt vmcnt(0)" ::: "memory");
            const unsigned og = xb_add(&bar[XB_TOP], 1u);
            const unsigned tg = og / nx;
            if (og + 1u == (tg + 1u) * nx) xb_add(&bar[XB_TOPGEN], 1u);
            else XB_SPIN(xb_ld(&bar[XB_TOPGEN]) == tg, bar);
            __builtin_amdgcn_fence(__ATOMIC_ACQUIRE, "agent");
            xb_add(&bar[XB_XGEN(bx_)], 1u);
            asm volatile("s_waitcnt vmcnt(0)" ::: "memory");
        } else {
            XB_SPIN(xb_ld(&bar[XB_XGEN(bx_)]) == gen, bar);
            __builtin_amdgcn_fence(__ATOMIC_ACQUIRE, "agent");
            asm volatile("s_waitcnt vmcnt(0)" ::: "memory");
        }
    }
    __syncthreads();
}

#define KSWZ(row, colB) ((row) * 256 + ((colB) ^ (((row) & 7) << 4)))
#define SBAR() __builtin_amdgcn_sched_barrier(0)
__device__ __forceinline__ int crow(int r, int hi) { return (r & 3) + 8 * (r >> 2) + 4 * hi; }
__device__ __forceinline__ int v_st(int k, int c) { const int kk = (k & ~0xC) | ((k & 4) << 1) | ((k & 8) >> 1); return ((kk >> 3) * 4 + (c >> 5)) * 512 + ((kk & 7) * 32 + (c & 31)) * 2; }
__device__ __forceinline__ int v_rd_base(int lane) { return ((lane & 3) << 3) | (((lane >> 2) & 3) << 6) | (((lane >> 4) & 1) << 5) | (((lane >> 5) & 1) << 8); }
constexpr int v_rd_off(int d0, int ks, int half) { return d0 * 512 + ks * 4096 + half * 2048; }
template <int OFF> __device__ __forceinline__ s16x4 tr_read(unsigned vb) {
    s16x4 r; asm volatile("ds_read_b64_tr_b16 %0, %1 offset:%2" : "=&v"(r) : "v"(vb), "i"(OFF) : "memory"); return r;
}
template <int D0> __device__ __forceinline__ void pv_one(f32x16& od, unsigned vb, bf16x8 pa0, bf16x8 pa1, bf16x8 pa2, bf16x8 pa3) {
    const s16x4 l0 = tr_read<v_rd_off(D0, 0, 0)>(vb), h0 = tr_read<v_rd_off(D0, 0, 1)>(vb), l1 = tr_read<v_rd_off(D0, 1, 0)>(vb), h1 = tr_read<v_rd_off(D0, 1, 1)>(vb);
    const s16x4 l2 = tr_read<v_rd_off(D0, 2, 0)>(vb), h2 = tr_read<v_rd_off(D0, 2, 1)>(vb), l3 = tr_read<v_rd_off(D0, 3, 0)>(vb), h3 = tr_read<v_rd_off(D0, 3, 1)>(vb);
    asm volatile("s_waitcnt lgkmcnt(0)" ::: "memory"); SBAR();
#define PK(L, H) (bf16x8){L[0], L[1], L[2], L[3], H[0], H[1], H[2], H[3]}
    od = __builtin_amdgcn_mfma_f32_32x32x16_bf16(pa0, PK(l0, h0), od, 0, 0, 0);
    od = __builtin_amdgcn_mfma_f32_32x32x16_bf16(pa1, PK(l1, h1), od, 0, 0, 0);
    od = __builtin_amdgcn_mfma_f32_32x32x16_bf16(pa2, PK(l2, h2), od, 0, 0, 0);
    od = __builtin_amdgcn_mfma_f32_32x32x16_bf16(pa3, PK(l3, h3), od, 0, 0, 0);
#undef PK
}
#define PK4(P, BASE, OUT) do { unsigned a0 = cvt_pk_bf16(P[BASE + 0], P[BASE + 1]), a1 = cvt_pk_bf16(P[BASE + 2], P[BASE + 3]);   \
    unsigned b0 = cvt_pk_bf16(P[BASE + 4], P[BASE + 5]), b1 = cvt_pk_bf16(P[BASE + 6], P[BASE + 7]);                              \
    auto r0 = __builtin_amdgcn_permlane32_swap(a0, b0, false, false); auto r1 = __builtin_amdgcn_permlane32_swap(a1, b1, false, false); \
    u32x4 w = {r0[0], r1[0], r0[1], r1[1]}; OUT = __builtin_bit_cast(bf16x8, w); } while (0)

constexpr int AL_K = 0, AL_V = 16384, AL_WS = 32768  , AL_CQ = 34816  , AL_CK = 35840  , AL_FLAG = 36352  , AL_QIDX = 36416, AL_Q = 40960  ;

struct AttnItem {
    int sb;
    int nq, t0, Kc, Knew_cnt;
    const bf16_t* Q;
    const float* Kcache; const float* Vcache;
    const bf16_t* Knew; const bf16_t* Vnew;
    const float* Lcache; const float* Lnew;
    float kn2;
    bf16_t* O;
};

__device__ __forceinline__ bf16x8 cvt8(const f32x4 a, const f32x4 b) {
    u32x4 w = {cvt_pk_bf16(a[0], a[1]), cvt_pk_bf16(a[2], a[3]), cvt_pk_bf16(b[0], b[1]), cvt_pk_bf16(b[2], b[3])}; return __builtin_bit_cast(bf16x8, w);
}
template <int SB> __device__ __forceinline__ void attn_item(const AttnItem& it, LAS unsigned char* lds) {
    int tid = threadIdx.x; asm volatile("" : "+v"(tid));
    const int lane = tid & 63, r32 = lane & 31, hi = lane >> 5; const int wid = __builtin_amdgcn_readfirstlane(tid >> 6);
    LAS unsigned char* K_lds = lds + AL_K; LAS unsigned char* V_lds = lds + AL_V;
    LAS float* wsf = (LAS float*)(lds + AL_WS) + wid * 64;
    LAS float* cq_l = (LAS float*)(lds + AL_CQ); LAS float* ck_l = (LAS float*)(lds + AL_CK); volatile LAS unsigned* flag_l = (volatile LAS unsigned*)(lds + AL_FLAG);
    const bool active = (32 * wid < it.nq);
    constexpr int sb = SB;
    LAS unsigned char* Q_lds = lds + AL_Q + wid * 8192;
    float qn = 0.f, cq = 0.f;
    if (active) {
        const bf16_t* Qw = it.Q + (size_t)(32 * wid + r32) * NPROJ + hi * 8;
        float s2 = 0.f;
#pragma unroll
        for (int d0 = 0; d0 < 8; ++d0) { const bf16x8 qv = *(const bf16x8*)(Qw + d0 * 16);
            *(LAS bf16x8*)(Q_lds + KSWZ(r32, (d0 * 16 + hi * 8) * 2)) = qv;
            const u32x4 w = __builtin_bit_cast(u32x4, qv);
#pragma unroll
            for (int i = 0; i < 4; ++i) { const float a = bf_lo(w[i]), b = bf_hi(w[i]); s2 += a * a + b * b; } }
        s2 += partner32(s2, hi);
        qn = sqrtf(s2);
    }
    if (!sb) {
        if (wid == 7) {
            float v[4]; float s = 0.f;
#pragma unroll
            for (int i = 0; i < 4; ++i) { const int idx = 4 * lane + i; const int pn = it.t0 - it.Kc + idx; v[i] = (idx < it.nq) ? it.Lnew[(size_t)pn * 6] : 0.f; s += v[i]; }
            float incl = s;
#pragma unroll
            for (int o = 1; o < 64; o <<= 1) { const float t = bperm((lane - o) & 63, incl); if (lane >= o) incl += t; }
            float run = incl - s;
#pragma unroll
            for (int i = 0; i < 4; ++i) { run += v[i]; cq_l[4 * lane + i] = run; }
        }
        __syncthreads();
        cq = cq_l[32 * wid + r32];
    }
    const float knorm = sqrtf(it.kn2) * 1.01f;
    float R = 0.f, m_run = -1e30f, l_run = 0.f, tot = 0.f;
    f32x16 o[4];
#pragma unroll
    for (int d = 0; d < 4; ++d) o[d] = f32x16{};
    bool done = !active;
    const int qpos = it.t0 + 32 * wid + r32, qpos_max = it.t0 + 32 * wid + 31;
    const int sr = tid >> 4, sc = (tid & 15) * 8;
    const unsigned vb = (unsigned)(uintptr_t)V_lds + (unsigned)v_rd_base(lane);
    const int jstart = (it.t0 + it.nq - 1) >> 6;
    for (int j = jstart; j >= 0; --j) {
        {
            bf16x8 k0, k1, v0, v1;
            const bf16x8 zero8 = (bf16x8){0, 0, 0, 0, 0, 0, 0, 0};
            if (64 * j < it.Kc) {
                const unsigned off = (unsigned)(64 * j + sr) * 3072u + (unsigned)sc * 4u;
                const char* kc = (const char*)it.Kcache; const char* vc = (const char*)it.Vcache;
                const f32x4 a0 = *(const f32x4*)(kc + off), a1 = *(const f32x4*)(kc + off + 16), a2 = *(const f32x4*)(kc + 98304 + off), a3 = *(const f32x4*)(kc + 98304 + off + 16);
                const f32x4 c0 = *(const f32x4*)(vc + off), c1 = *(const f32x4*)(vc + off + 16), c2 = *(const f32x4*)(vc + 98304 + off), c3 = *(const f32x4*)(vc + 98304 + off + 16);
                k0 = cvt8(a0, a1); k1 = cvt8(a2, a3); v0 = cvt8(c0, c1); v1 = cvt8(c2, c3);
            } else {
                const int pn0 = 64 * j - it.Kc;
                const unsigned off = (unsigned)(pn0 + sr) * (unsigned)(NPROJ * 2) + (unsigned)sc * 2u;
                const char* kn = (const char*)it.Knew; const char* vn = (const char*)it.Vnew;
                k0 = zero8; k1 = zero8; v0 = zero8; v1 = zero8;
                if (pn0 < it.Knew_cnt) { k0 = *(const bf16x8*)(kn + off); v0 = *(const bf16x8*)(vn + off); }
                if (pn0 + 32 < it.Knew_cnt) { k1 = *(const bf16x8*)(kn + 32 * NPROJ * 2 + off); v1 = *(const bf16x8*)(vn + 32 * NPROJ * 2 + off); }
            }
            *(LAS bf16x8*)(K_lds + KSWZ(sr, sc * 2)) = k0; *(LAS bf16x8*)(K_lds + KSWZ(sr, sc * 2) + 8192) = k1;
            *(LAS bf16x8*)(V_lds + v_st(sr, sc)) = v0; *(LAS bf16x8*)(V_lds + v_st(32 + sr, sc)) = v1;
        }
        if (!sb && wid == 7) {
            const int p = 64 * j + lane;
            if (64 * j >= it.t0) {
                const int idx = p - it.t0;
                ck_l[lane] = (idx < it.nq) ? cq_l[idx] : 0.f;
                if (lane == 0) ck_l[64] = (64 * j > it.t0) ? cq_l[64 * j - 1 - it.t0] : 0.f;
            } else {
                float L;
                if (p < it.Kc) L = it.Lcache[(size_t)p * 6]; else L = it.Lnew[(size_t)(p - it.Kc) * 6];
                float suf = L;
#pragma unroll
                for (int o = 1; o < 64; o <<= 1) { const float t = bperm((lane + o) & 63, suf); if (lane + o < 64) suf += t; }
                ck_l[lane] = tot - (suf - L);
                const float total = __builtin_amdgcn_readfirstlane(suf);
                tot -= total;
                if (lane == 0) ck_l[64] = tot;
            }
        }
        __syncthreads();
        if (!done && 64 * j <= qpos_max) {
            f32x16 p0 = f32x16{}, p1 = f32x16{};
            {
                const int swz = (r32 & 7) << 4;
#pragma unroll
                for (int d = 0; d < 4; ++d) { const int ka = r32 * 256 + ((d * 32 + hi * 16) ^ swz);
#pragma unroll
                    for (int dh = 0; dh < 2; ++dh) {
                        const bf16x8 b0 = *(const LAS bf16x8*)(K_lds + ka + dh * 128);
                        const bf16x8 b1 = *(const LAS bf16x8*)(K_lds + ka + dh * 128 + 8192);
                        const bf16x8 qf = *(const LAS bf16x8*)(Q_lds + ka + dh * 128);
                        p0 = __builtin_amdgcn_mfma_f32_32x32x16_bf16(b0, qf, p0, 0, 0, 0);
                        p1 = __builtin_amdgcn_mfma_f32_32x32x16_bf16(b1, qf, p1, 0, 0, 0); } }
            }
            const int kb = 64 * j + 4 * hi;
            bf16x8 pa0, pa1, pa2, pa3;
            if (sb) {
                float run = R;
#define SB_GROUP(P, g, KOFF) do { float z_[4], l_[4]; \
                    _Pragma("unroll") for (int i_ = 0; i_ < 4; ++i_) { const float z = P[4 * (g) + i_] * QK_SCALE; const float sp = lg2(1.f + ex2(-fabsf(z) * LOG2E)) * LN2; \
                        const bool ok = (kb + (KOFF) + 8 * (g) + i_) < qpos; l_[i_] = ok ? -(fmaxf(z, 0.f) + sp) : 0.f; z_[i_] = ok ? z : -INFINITY; } \
                    const float gs = (l_[0] + l_[1]) + (l_[2] + l_[3]); const float gp = partner32(gs, hi); \
                    float lat = run + (hi ? 0.f : gp); \
                    P[4 * (g) + 3] = ex2((z_[3] + l_[3] + lat) * LOG2E); lat += l_[3]; \
                    P[4 * (g) + 2] = ex2((z_[2] + l_[2] + lat) * LOG2E); lat += l_[2]; \
                    P[4 * (g) + 1] = ex2((z_[1] + l_[1] + lat) * LOG2E); lat += l_[1]; \
                    P[4 * (g) + 0] = ex2((z_[0] + l_[0] + lat) * LOG2E); \
                    run += gs + gp; SBAR(); } while (0)
                SB_GROUP(p1, 3, 32); SB_GROUP(p1, 2, 32); SB_GROUP(p1, 1, 32); SB_GROUP(p1, 0, 32);
                SB_GROUP(p0, 3, 0); SB_GROUP(p0, 2, 0); SB_GROUP(p0, 1, 0); SB_GROUP(p0, 0, 0);
#undef SB_GROUP
                R = run;
                PK4(p0, 0, pa0); PK4(p0, 8, pa1); PK4(p1, 0, pa2); PK4(p1, 8, pa3);
                done = __all(R < -EXIT_T);
            } else {
                float pmax = -INFINITY;
#pragma unroll
                for (int g = 0; g < 4; ++g) {
                    const f32x4 c0 = *(const LAS f32x4*)(ck_l + 8 * g + 4 * hi), c1 = *(const LAS f32x4*)(ck_l + 32 + 8 * g + 4 * hi);
#pragma unroll
                    for (int i = 0; i < 4; ++i) { const int r = 4 * g + i; const int kp = kb + i + 8 * g;
                        const float s0 = p0[r] * QK_SCALE + (cq - c0[i]), s1 = p1[r] * QK_SCALE + (cq - c1[i]);
                        p0[r] = (kp <= qpos) ? s0 : -INFINITY; p1[r] = (kp + 32 <= qpos) ? s1 : -INFINITY;
                        pmax = fmaxf(pmax, fmaxf(p0[r], p1[r])); }
                    SBAR();
                }
                pmax = fmaxf(pmax, partner32(pmax, hi));
                const float mnew = fmaxf(m_run, pmax);
                const float alpha = ex2((m_run - mnew) * LOG2E);
                float ps = 0.f;
#pragma unroll
                for (int r = 0; r < 16; ++r) { p0[r] = ex2((p0[r] - mnew) * LOG2E); p1[r] = ex2((p1[r] - mnew) * LOG2E); ps += p0[r] + p1[r]; if ((r & 3) == 3) SBAR(); }
                ps += partner32(ps, hi);
                l_run = l_run * alpha + ps; m_run = mnew;
                if (__any(alpha != 1.f)) {
                    if (hi == 0) wsf[r32] = alpha;
                    LDS_WAIT();
#pragma unroll
                    for (int r = 0; r < 16; ++r) { const float a = wsf[crow(r, hi)];
#pragma unroll
                        for (int d = 0; d < 4; ++d) o[d][r] *= a; }
                }
                PK4(p0, 0, pa0); PK4(p0, 8, pa1); PK4(p1, 0, pa2); PK4(p1, 8, pa3);
                const float zb = qn * knorm * QK_SCALE + (cq - ck_l[64]);
                done = __all(zb - m_run < -EXIT_T);
            }
            pv_one<0>(o[0], vb, pa0, pa1, pa2, pa3); pv_one<1>(o[1], vb, pa0, pa1, pa2, pa3); pv_one<2>(o[2], vb, pa0, pa1, pa2, pa3); pv_one<3>(o[3], vb, pa0, pa1, pa2, pa3);
        }
        if (lane == 0) flag_l[wid] = done ? 1u : 0u;
        __syncthreads();
        unsigned all = 1u;
#pragma unroll
        for (int w = 0; w < 8; ++w) all &= flag_l[w];
        if (all) break;
    }
    if (active) {
        float rli[16];
        if (!sb) {
            if (hi == 0) wsf[32 + r32] = 1.0f / l_run;
            LDS_WAIT();
#pragma unroll
            for (int r = 0; r < 16; ++r) rli[r] = wsf[32 + crow(r, hi)];
        } else {
#pragma unroll
            for (int r = 0; r < 16; ++r) rli[r] = 1.f;
        }
        bf16_t* Ow = it.O + (size_t)(32 * wid) * DM;
#pragma unroll
        for (int r = 0; r < 16; ++r) { const int orow = crow(r, hi);
#pragma unroll
            for (int d0 = 0; d0 < 4; ++d0) { const unsigned w = cvt_pk_bf16(o[d0][r] * rli[r], 0.f); Ow[(size_t)orow * DM + d0 * 32 + r32] = (bf16_t)(w & 0xffffu); } }
    }
    __syncthreads();
}

__device__ __forceinline__ void conv_item(int cb, int layer, const bf16_t* proj, bf16_t* Y, const float* state_conv, const float* conv_w, float* out) {
    int tid = threadIdx.x; asm volatile("" : "+v"(tid));
    const int lane = tid & 63, wid = tid >> 6;
    const int c8 = lane * 8, g0 = 64 * cb + 8 * wid;
    const bool sample = g0 >= SEQ;
    const int b = sample ? (g0 - SEQ) / DSEQ : 0;
    const int seq0 = sample ? SEQ + DSEQ * b : 0, seq_end = sample ? seq0 + DSEQ : SEQ;
    float w0[8], w1[8], w2[8], um2[8], um1[8];
    { const float* cw = conv_w + (size_t)layer * 3 * CONVD + c8;
      const f32x4 a0 = *(const f32x4*)cw, a1 = *(const f32x4*)(cw + 4), b0 = *(const f32x4*)(cw + CONVD), b1 = *(const f32x4*)(cw + CONVD + 4), c0 = *(const f32x4*)(cw + 2 * CONVD), c1 = *(const f32x4*)(cw + 2 * CONVD + 4);
#pragma unroll
      for (int i = 0; i < 4; ++i) { w0[i] = a0[i]; w0[4 + i] = a1[i]; w1[i] = b0[i]; w1[4 + i] = b1[i]; w2[i] = c0[i]; w2[4 + i] = c1[i]; } }
    auto load_u = [&](int t, float (&u)[8]) {
        const u32x4 gc = *(const u32x4*)(proj + (size_t)t * NPROJ + C_GC + c8), hc = *(const u32x4*)(proj + (size_t)t * NPROJ + C_HC + c8);
#pragma unroll
        for (int i = 0; i < 4; ++i) { u[2 * i] = bf_lo(gc[i]) * bf_lo(hc[i]); u[2 * i + 1] = bf_hi(gc[i]) * bf_hi(hc[i]); }
    };
    if (g0 == seq0) {
        if (sample) { const float* st = state_conv + ((size_t)(layer * DB + b) * 2) * CONVD + c8;
            const f32x4 a0 = *(const f32x4*)st, a1 = *(const f32x4*)(st + 4), b0 = *(const f32x4*)(st + CONVD), b1 = *(const f32x4*)(st + CONVD + 4);
#pragma unroll
            for (int i = 0; i < 4; ++i) { um2[i] = a0[i]; um2[4 + i] = a1[i]; um1[i] = b0[i]; um1[4 + i] = b1[i]; } }
        else {
#pragma unroll
            for (int i = 0; i < 8; ++i) { um2[i] = 0.f; um1[i] = 0.f; } }
    } else { load_u(g0 - 2, um2); load_u(g0 - 1, um1); }
#pragma unroll 1
    for (int t = g0; t < g0 + 8; ++t) {
        float u[8]; load_u(t, u);
        const u32x4 gb = *(const u32x4*)(proj + (size_t)t * NPROJ + C_GB + c8);
        float y[8];
#pragma unroll
        for (int i = 0; i < 4; ++i) {
            y[2 * i] = bf_lo(gb[i]) * (w0[2 * i] * um2[2 * i] + w1[2 * i] * um1[2 * i] + w2[2 * i] * u[2 * i]);
            y[2 * i + 1] = bf_hi(gb[i]) * (w0[2 * i + 1] * um2[2 * i + 1] + w1[2 * i + 1] * um1[2 * i + 1] + w2[2 * i + 1] * u[2 * i + 1]);
        }
        u32x4 w; w.x = cvt_pk_bf16(y[0], y[1]); w.y = cvt_pk_bf16(y[2], y[3]); w.z = cvt_pk_bf16(y[4], y[5]); w.w = cvt_pk_bf16(y[6], y[7]);
        *(u32x4*)(Y + (size_t)t * DM + c8) = w;
        if (t >= seq_end - 2) {
            const int which = t - (seq_end - 2);
            float* dst = sample ? out + O_SCONV + ((size_t)(layer * DB + b) * 2 + which) * CONVD + c8 : out + O_PCONV + ((size_t)layer * 2 + which) * CONVD + c8;
            *(f32x4*)dst = (f32x4){u[0], u[1], u[2], u[3]}; *(f32x4*)(dst + 4) = (f32x4){u[4], u[5], u[6], u[7]};
        }
#pragma unroll
        for (int i = 0; i < 8; ++i) { um2[i] = um1[i]; um1[i] = u[i]; }
    }
}

__device__ __forceinline__ void p0_transpose_item(const float* W, int ldw, int k0, int n0, const float* g, bf16_t* WT, int K, int drow0, LAS float* scr, int lane) {
    f32x2 v[16];
    const int kq = lane >> 4, nn = (lane & 15) * 2;
#pragma unroll
    for (int i = 0; i < 16; ++i) v[i] = *(const f32x2*)(W + (size_t)(k0 + 4 * i + kq) * ldw + n0 + nn);
#pragma unroll
    for (int i = 0; i < 16; ++i) { scr[(4 * i + kq) * 33 + nn] = v[i].x; scr[(4 * i + kq) * 33 + nn + 1] = v[i].y; }
    LDS_WAIT(); asm volatile("" ::: "memory");
    const int c = lane & 7;
    float gv[8];
    if (g) { const f32x4 a = *(const f32x4*)(g + k0 + 8 * c), b = *(const f32x4*)(g + k0 + 8 * c + 4);
#pragma unroll
        for (int i = 0; i < 4; ++i) { gv[i] = a[i]; gv[4 + i] = b[i]; } }
    else {
#pragma unroll
        for (int i = 0; i < 8; ++i) gv[i] = 1.f; }
#pragma unroll
    for (int j = 0; j < 4; ++j) { const int n = (lane >> 3) + 8 * j; const LAS float* s = scr + (8 * c) * 33 + n;
        u32x4 o; o.x = cvt_pk_bf16(s[0 * 33] * gv[0], s[1 * 33] * gv[1]); o.y = cvt_pk_bf16(s[2 * 33] * gv[2], s[3 * 33] * gv[3]);
        o.z = cvt_pk_bf16(s[4 * 33] * gv[4], s[5 * 33] * gv[5]); o.w = cvt_pk_bf16(s[6 * 33] * gv[6], s[7 * 33] * gv[7]);
        *(u32x4*)(WT + (size_t)(drow0 + n) * K + k0 + 8 * c) = o; }
    LDS_WAIT(); asm volatile("" ::: "memory");
}

#ifndef PB_MASK
#define PB_MASK 31
#endif
#ifndef STOP_AFTER
#define STOP_AFTER 99
#endif
struct Params { const float* in[18]; float* out; unsigned char* ws; };
enum { I_XP = 0, I_XS, I_SCONV, I_CSBK, I_CSBV, I_CFK, I_CFV, I_CLOGF, I_N1G, I_WIN, I_BF, I_CONVW, I_WOUT, I_N2G, I_WGATE, I_WUP, I_WDOWN, I_FG };

__global__ void __launch_bounds__(512, 2) hybrid_fwd(Params P) {
    extern __shared__ __attribute__((aligned(16))) unsigned char lds_raw[];
    LAS unsigned char* lds = (LAS unsigned char*)lds_raw;
    volatile LAS unsigned* MISC = (volatile LAS unsigned*)(lds + MISC_OFF);
    const int tid = threadIdx.x, lane = tid & 63; const int wave = __builtin_amdgcn_readfirstlane(tid >> 6);
    const int G = gridDim.x; const int bx = blockIdx.x; const int vcu = (G % 8 == 0) ? (bx % 8) * (G / 8) + bx / 8 : bx;
    const int gw = vcu * 8 + wave, NGW = G * 8;
    unsigned char* ws = P.ws;
    unsigned* ctl = (unsigned*)(ws + WS_CTL);
    float* out = P.out;
    float* WF = (float*)(ws + WS_WF);
    bf16_t* WIN = (bf16_t*)(ws + WS_WIN); bf16_t* WOUT = (bf16_t*)(ws + WS_WOUT); bf16_t* WGU = (bf16_t*)(ws + WS_WGU); bf16_t* WDN = (bf16_t*)(ws + WS_WDN);
    bf16_t* XB = (bf16_t*)(ws + WS_XB); float* XF = (float*)(ws + WS_XF); bf16_t* PROJ = (bf16_t*)(ws + WS_PROJ); bf16_t* Y = (bf16_t*)(ws + WS_Y); bf16_t* H = (bf16_t*)(ws + WS_H);
    float* SSQ = (float*)(ctl + CW_SSQ);
    for (int u = tid; u < (LDS_BYTES - RING_BYTES) / 4; u += 512) ((LAS unsigned*)(lds + RING_BYTES))[u] = 0u;
    __syncthreads();
    XcdBarrier bar = xcd_barrier_post(ctl + CW_BAR, MISC + 8);

    {
        LAS float* scr = (LAS float*)(lds + wave * 16384);
        constexpr int I_IN = 32 * 192, I_OUT = 32 * 64, I_G = 32 * 176, I_D = 88 * 64, I_L = I_IN + I_OUT + 2 * I_G + I_D, NITEMS = 2 * I_L;
        for (int it = gw; it < NITEMS; it += NGW) {
            const int l = it / I_L; int r = it % I_L;
            if (r < I_IN) { const int kb = r / 192, nb = r % 192;
                p0_transpose_item(P.in[I_WIN] + (size_t)l * DM * IN_DIM, IN_DIM, 64 * kb, 32 * nb, P.in[I_N1G] + l * DM, WIN + l * WIN_L, DM, 32 * nb, scr, lane); continue; }
            r -= I_IN;
            if (r < I_OUT) { const int kb = r / 64, nb = r % 64;
                p0_transpose_item(P.in[I_WOUT] + (size_t)l * DM * DM, DM, 64 * kb, 32 * nb, nullptr, WOUT + l * WOUT_L, DM, 32 * nb, scr, lane); continue; }
            r -= I_OUT;
            if (r < 2 * I_G) { const int up = r / I_G; r %= I_G; const int kb = r / 176, nb = r % 176; const int n0 = 32 * nb;
                p0_transpose_item(P.in[up ? I_WUP : I_WGATE] + (size_t)l * DM * DFF, DFF, 64 * kb, n0, P.in[I_N2G] + l * DM, WGU + l * WGU_L, DM, 256 * (n0 / 128) + 128 * up + (n0 % 128), scr, lane); continue; }
            r -= 2 * I_G;
            { const int kb = r / 64, nb = r % 64;
                p0_transpose_item(P.in[I_WDOWN] + (size_t)l * DFF * DM, DM, 64 * kb, 32 * nb, nullptr, WDN + l * WDN_L, DFF, 32 * nb, scr, lane); }
        }
        for (int r = gw; r < MT; r += NGW) {
            const float* xr = (r < SEQ) ? P.in[I_XP] + (size_t)r * DM : P.in[I_XS] + (size_t)(r - SEQ) * DM;
            float s = 0.f;
#pragma unroll
            for (int i = 0; i < 4; ++i) {
                const f32x4 a = *(const f32x4*)(xr + 8 * lane + 512 * i), b = *(const f32x4*)(xr + 8 * lane + 512 * i + 4);
                s += (a[0] * a[0] + a[1] * a[1]) + (a[2] * a[2] + a[3] * a[3]) + (b[0] * b[0] + b[1] * b[1]) + (b[2] * b[2] + b[3] * b[3]);
                u32x4 w; w.x = cvt_pk_bf16(a[0], a[1]); w.y = cvt_pk_bf16(a[2], a[3]); w.z = cvt_pk_bf16(b[0], b[1]); w.w = cvt_pk_bf16(b[2], b[3]);
                *(u32x4*)(XB + (size_t)r * DM + 8 * lane + 512 * i) = w;
            }
            s = wave_sum(s);
            if (lane == 0) SSQ[r] = s;
        }
        for (int e = vcu * 512 + tid; e < 2 * 6 * DM; e += G * 512) {
            const int l = e / (6 * DM), j = (e % (6 * DM)) / DM, k = e % DM;
            WF[e] = P.in[I_N1G][l * DM + k] * P.in[I_WIN][((size_t)l * DM + k) * IN_DIM + NPROJ + j];
        }
        for (int it = gw; it < 2 * DB * (PAST / 16); it += NGW) {
            const int lb = it / (PAST / 16), s0 = (it % (PAST / 16)) * 16;
            const float* base = P.in[I_CFK] + ((size_t)lb * PAST + s0) * 768;
            const int half = lane >> 5, c4 = (lane & 31) * 4;
            float hm[6];
#pragma unroll
            for (int h = 0; h < 6; ++h) hm[h] = 0.f;
#pragma unroll 1
            for (int pp = 0; pp < 8; ++pp)
#pragma unroll
                for (int h = 0; h < 6; ++h) {
                    const f32x4 v = *(const f32x4*)(base + (size_t)((2 * pp + half) * 6 + h) * 128 + c4);
                    float ss = (v[0] * v[0] + v[1] * v[1]) + (v[2] * v[2] + v[3] * v[3]);
                    ss = swap16_sum(row16_sum(ss));
                    hm[h] = fmaxf(hm[h], ss);
                }
#pragma unroll
            for (int h = 0; h < 6; ++h) { const float mx = swap32_max(hm[h]); if (lane == 0) atomicMax(ctl + CW_KMAXC + lb * NH + h, __float_as_uint(mx)); }
        }
    }
    xcd_barrier(bar);

    for (int l = 0; l < 2; ++l) {
        int lane = tid & 63; asm volatile("" : "+v"(lane));
        long zoff = 0; asm volatile("" : "+s"(zoff));
        unsigned char* ws = P.ws + zoff; float* out = P.out + zoff;
        unsigned* ctl = (unsigned*)(ws + WS_CTL);
        float* WF = (float*)(ws + WS_WF);
        bf16_t* WIN = (bf16_t*)(ws + WS_WIN); bf16_t* WOUT = (bf16_t*)(ws + WS_WOUT); bf16_t* WGU = (bf16_t*)(ws + WS_WGU); bf16_t* WDN = (bf16_t*)(ws + WS_WDN);
        bf16_t* XB = (bf16_t*)(ws + WS_XB); float* XF = (float*)(ws + WS_XF); bf16_t* PROJ = (bf16_t*)(ws + WS_PROJ); bf16_t* Y = (bf16_t*)(ws + WS_Y); bf16_t* H = (bf16_t*)(ws + WS_H);
        float* SSQ = (float*)(ctl + CW_SSQ);
        const float* ssq_in = SSQ + (size_t)(2 * l) * MT;
        float* ssq_mid = SSQ + (size_t)(2 * l + 1) * MT;
        float* ssq_next = SSQ + (size_t)(2 * l + 2) * MT;
        const float* base_p = (l == 0) ? P.in[I_XP] : XF;
        const float* base_s = (l == 0) ? P.in[I_XS] : XF + (size_t)SEQ * DM;
        {
            const float* wf = WF + (size_t)l * 6 * DM;
            for (int r = gw; r < MT; r += NGW) {
                const float* xr = (r < SEQ) ? base_p + (size_t)r * DM : base_s + (size_t)(r - SEQ) * DM;
                f32x4 xv[8];
#pragma unroll
                for (int i = 0; i < 8; ++i) xv[i] = *(const f32x4*)(xr + 4 * lane + 256 * i);
                const float rs = rsqrtf(ssq_in[r] * (1.0f / DM) + EPS);
                float val = 0.f;
#pragma unroll 1
                for (int j = 0; j < 6; ++j) { float s = 0.f;
#pragma unroll
                    for (int i = 0; i < 8; ++i) { const f32x4 w = *(const f32x4*)(wf + j * DM + 4 * lane + 256 * i); s += (xv[i][0] * w[0] + xv[i][1] * w[1]) + (xv[i][2] * w[2] + xv[i][3] * w[3]); }
                    const float f = wave_sum(s) * rs + P.in[I_BF][l * NH + j]; const float lf = fminf(f, 0.f) - log1pf(expf(-fabsf(f))); val = (lane == j) ? lf : val; }
                float* dst = (r < SEQ) ? out + O_PLOGF + ((size_t)l * SEQ + r) * 6 : out + O_SLOGF + ((size_t)l * NSMP + (r - SEQ)) * 6;
                if (lane < 6) dst[lane] = val;
            }
            pg8::Gemm g{XB, WIN + l * WIN_L, MT, NPROJ, DM}; pg8::StaticOrder S; S.init(MT, NPROJ, G, bx);
            pg8::EpiProj E{PROJ, ssq_in, out, l, ctl + CW_KMAXP, ctl + CW_KMAXS};
            pg8::gemm_phase<pg8::EpiProj, pg8::StaticOrder, true, true>(lds, g, S, E);
        }
        xcd_barrier(bar);
        if (STOP_AFTER == 1 + 5 * l) return;
        {
            constexpr int N_PA = 2 * 32 * NH, N_SA = 2 * DB * NH, N_CV = MT / 64, N_ALL = N_PA + N_SA + N_CV;
            volatile LAS unsigned* qidx = (volatile LAS unsigned*)(lds + AL_QIDX);
            for (;;) {
                if (tid == 0) qidx[0] = __hip_atomic_fetch_add(ctl + CW_Q + 64 * l, 1u, __ATOMIC_RELAXED, __HIP_MEMORY_SCOPE_AGENT);
                __syncthreads();
                const int idx = (int)qidx[0];
                __syncthreads();
                if (idx >= N_ALL) break;
                if (idx < N_PA + N_SA) {
                    AttnItem it;
                    int type, h, b = 0;
                    if (idx < N_PA) { type = idx / (32 * NH); const int rem = idx % (32 * NH); const int qt = 31 - rem / NH; h = rem % NH;
                        it.nq = 256; it.t0 = 256 * qt; it.Kc = 0; it.Knew_cnt = SEQ;
                        it.Q = PROJ + (size_t)it.t0 * NPROJ; it.Knew = PROJ; it.Vnew = PROJ; it.Kcache = nullptr; it.Vcache = nullptr; it.Lcache = nullptr;
                        it.Lnew = out + O_PLOGF + (size_t)l * SEQ * 6 + h; it.O = Y + (size_t)it.t0 * DM;
                        const unsigned* km = ctl + CW_KMAXP + (l * NH + h) * 4;
                        it.kn2 = (__uint_as_float(km[0]) + __uint_as_float(km[1])) + (__uint_as_float(km[2]) + __uint_as_float(km[3]));
                    } else { const int k = idx - N_PA; type = k / (DB * NH); b = (k % (DB * NH)) / NH; h = k % NH;
                        it.nq = DSEQ; it.t0 = PAST; it.Kc = PAST; it.Knew_cnt = DSEQ;
                        const size_t row0 = (size_t)SEQ + DSEQ * b;
                        it.Q = PROJ + row0 * NPROJ; it.Knew = PROJ + row0 * NPROJ; it.Vnew = PROJ + row0 * NPROJ;
                        const size_t coff = ((size_t)(l * DB + b) * PAST) * 768 + h * HD;
                        it.Kcache = P.in[type == 0 ? I_CSBK : I_CFK] + coff; it.Vcache = P.in[type == 0 ? I_CSBV : I_CFV] + coff;
                        it.Lcache = P.in[I_CLOGF] + ((size_t)(l * DB + b) * PAST) * 6 + h;
                        it.Lnew = out + O_SLOGF + ((size_t)l * NSMP + DSEQ * b) * 6 + h; it.O = Y + row0 * DM;
                        const unsigned* km = ctl + CW_KMAXS + ((l * DB + b) * NH + h) * 4;
                        const float kn_new = (__uint_as_float(km[0]) + __uint_as_float(km[1])) + (__uint_as_float(km[2]) + __uint_as_float(km[3]));
                        it.kn2 = fmaxf(kn_new, __uint_as_float(ctl[CW_KMAXC + (l * DB + b) * NH + h]));
                    }
                    it.sb = (type == 0);
                    const int cq_ = (type == 0 ? C_SQ : C_FQ) + h * HD, ck_ = (type == 0 ? C_SK : C_FK) + h * HD, cv_ = (type == 0 ? C_SV : C_FV) + h * HD;
                    it.Q += cq_; it.Knew += ck_; it.Vnew += cv_; it.O += (type == 0 ? CONVD : CONVD + NH * HD) + h * HD;
                    const int pbit = (idx < N_PA ? 1 : 4) << (type == 0 ? 0 : 1);
                    if (PB_MASK & pbit) { if (type == 0) attn_item<1>(it, lds); else attn_item<0>(it, lds); }
                } else {
                    if (PB_MASK & 16) conv_item(idx - (N_PA + N_SA), l, PROJ, Y, P.in[I_SCONV], P.in[I_CONVW], out);
                }
            }
        }
        xcd_barrier(bar);
        if (STOP_AFTER == 2 + 5 * l) {
            for (size_t e = (size_t)bx * 512 + tid; e < (size_t)SEQ * DM; e += (size_t)G * 512) out[O_YP + e] = bf_lo((unsigned)Y[e]);
            return; }
        {
            pg8::Gemm g{Y, WOUT + l * WOUT_L, MT, DM, DM}; pg8::StaticOrder S; S.init(MT, DM, G, bx);
            pg8::EpiRes E{base_p, base_s, XF, XB, ssq_mid};
            pg8::gemm_phase<pg8::EpiRes, pg8::StaticOrder, true, true>(lds, g, S, E);
        }
        xcd_barrier(bar);
        if (STOP_AFTER == 3 + 5 * l) {
            for (size_t e = (size_t)bx * 512 + tid; e < (size_t)SEQ * DM; e += (size_t)G * 512) out[O_YP + e] = XF[e];
            return; }
        {
            pg8::Gemm g{XB, WGU + l * WGU_L, MT, NGU, DM}; pg8::StaticOrder S; S.init(MT, NGU, G, bx);
            pg8::EpiGU E{H, ssq_mid};
            pg8::gemm_phase<pg8::EpiGU, pg8::StaticOrder, true, true>(lds, g, S, E);
        }
        xcd_barrier(bar);
        if (STOP_AFTER == 4 + 5 * l) {
            for (size_t e = (size_t)bx * 512 + tid; e < (size_t)SEQ * DM; e += (size_t)G * 512) out[O_YP + e] = bf_lo((unsigned)H[(e / DM) * DFF + (e % DM)]);
            return; }
        {
            pg8::Gemm g{H, WDN + l * WDN_L, MT, DM, DFF}; pg8::StaticOrder S; S.init(MT, DM, G, bx);
            pg8::EpiRes E{XF, XF + (size_t)SEQ * DM, XF, XB, ssq_next};
            pg8::gemm_phase<pg8::EpiRes, pg8::StaticOrder, true, true>(lds, g, S, E);
        }
        xcd_barrier(bar);
        if (STOP_AFTER == 5 + 5 * l) {
            for (size_t e = (size_t)bx * 512 + tid; e < (size_t)SEQ * DM; e += (size_t)G * 512) out[O_YP + e] = XF[e];
            return; }
    }
    {
        const float* ssq_f = SSQ + (size_t)4 * MT; const float* fg = P.in[I_FG];
        const unsigned tmo = __hip_atomic_load(ctl + CW_BAR + XB_TMO, __ATOMIC_RELAXED, __HIP_MEMORY_SCOPE_AGENT);
        for (int r = gw; r < MT; r += NGW) {
            float rs = rsqrtf(ssq_f[r] * (1.0f / DM) + EPS);
            if (tmo) rs = __builtin_nanf("");
            const float* xr = XF + (size_t)r * DM; float* yo = (r < SEQ) ? out + O_YP + (size_t)r * DM : out + O_YS + (size_t)(r - SEQ) * DM;
#pragma unroll
            for (int i = 0; i < 8; ++i) { const f32x4 x = *(const f32x4*)(xr + 4 * lane + 256 * i), gq = *(const f32x4*)(fg + 4 * lane + 256 * i);
                *(f32x4*)(yo + 4 * lane + 256 * i) = x * rs * gq; }
        }
    }
}

extern "C" void kernel_launch(void* const* d_in, const int* in_sizes, int n_in, void* d_out, int out_size, void* d_ws, size_t ws_size, hipStream_t stream) {
    static int grid = 0;
    if (grid == 0) {
        if (n_in != 18 || (size_t)out_size != O_TOTAL || ws_size < WS_END) { fprintf(stderr, "kernel_launch: unexpected shapes (n_in %d out %d ws %zu)\n", n_in, out_size, ws_size); grid = -1; return; }
        int dev = 0, cus = 0, per_cu = 0;
        if (hipGetDevice(&dev) != hipSuccess || hipDeviceGetAttribute(&cus, hipDeviceAttributeMultiprocessorCount, dev) != hipSuccess) { grid = -1; return; }
        if (hipFuncSetAttribute((const void*)hybrid_fwd, hipFuncAttributeMaxDynamicSharedMemorySize, LDS_BYTES) != hipSuccess) { fprintf(stderr, "kernel_launch: hipFuncSetAttribute failed\n"); grid = -1; return; }
        if (hipOccupancyMaxActiveBlocksPerMultiprocessor(&per_cu, (const void*)hybrid_fwd, 512, LDS_BYTES) != hipSuccess || per_cu < 1) { fprintf(stderr, "kernel_launch: occupancy query says %d\n", per_cu); }
        (void)hipGetLastError();
        grid = cus;
    }
    if (grid < 0) return;
    if (hipMemsetAsync((char*)d_ws + WS_CTL, 0, CTL_ZERO_BYTES, stream) != hipSuccess) return;
    Params p{};
    for (int i = 0; i < 18; ++i) p.in[i] = (const float*)d_in[i];
    p.out = (float*)d_out; p.ws = (unsigned char*)d_ws;
    hipLaunchKernelGGL(hybrid_fwd, dim3(grid), dim3(512), LDS_BYTES, stream, p);
}
```

```cpp
#include <hip/hip_runtime.h>
#include <cstdio>
#include <cstdint>
#include <cmath>

#define LAS __attribute__((address_space(3)))
#define GAS __attribute__((address_space(1)))
typedef unsigned short bf16_t;
typedef short bf16x8 __attribute__((ext_vector_type(8)));
typedef short s16x4 __attribute__((ext_vector_type(4)));
typedef float f32x2 __attribute__((ext_vector_type(2)));
typedef float f32x4 __attribute__((ext_vector_type(4)));
typedef float f32x16 __attribute__((ext_vector_type(16)));
typedef unsigned u32x2 __attribute__((ext_vector_type(2)));
typedef unsigned u32x4 __attribute__((ext_vector_type(4)));
typedef GAS unsigned gu32;

constexpr int DM = 2048, SEQ = 8192, NSMP = 256, MT = SEQ + NSMP  ;
constexpr int NPROJ = 6144, IN_DIM = 6150, DFF = 5632, NGU = 2 * DFF, PAST = 4096, DSEQ = 32, DB = 8, NH = 6, HD = 128, CONVD = 512;
constexpr int C_GB = 0, C_GC = 512, C_HC = 1024, C_SQ = 1536, C_SK = 2304, C_SV = 3072, C_FQ = 3840, C_FK = 4608, C_FV = 5376;
constexpr float EPS = 1e-5f, LOG2E = 1.4426950408889634f, LN2 = 0.6931471805599453f, QK_SCALE = 0.08838834764831845f;
constexpr float EXIT_T = 40.f;
constexpr size_t O_YP = 0, O_YS = 16777216, O_PCONV = 17301504, O_PSBK = 17303552, O_PSBV = 29886464, O_PFK = 42469376, O_PFV = 55052288, O_PLOGF = 67635200,
                 O_SCONV = 67733504, O_SSBK = 67749888, O_SSBV = 68143104, O_SFK = 68536320, O_SFV = 68929536, O_SLOGF = 69322752, O_TOTAL = 69325824;
constexpr size_t P_KV_STRIDE = (size_t)2 * SEQ * 768, S_KV_STRIDE = (size_t)2 * NSMP * 768;
constexpr size_t MiB = 1u << 20;
constexpr size_t WS_CTL = 0, CTL_ZERO_BYTES = 256 * 1024  , WS_WF = 1 * MiB, WS_WIN = 2 * MiB, WS_WOUT = 50 * MiB, WS_WGU = 66 * MiB, WS_WDN = 154 * MiB,
                 WS_XB = 198 * MiB, WS_XF = 231 * MiB, WS_PROJ = 297 * MiB, WS_Y = 396 * MiB, WS_H = 429 * MiB, WS_END = 520 * MiB;
constexpr size_t WIN_L = (size_t)NPROJ * DM, WOUT_L = (size_t)DM * DM, WGU_L = (size_t)NGU * DM, WDN_L = (size_t)DM * DFF;
constexpr int CW_BAR = 4096, CW_Q = 8192, CW_KMAXP = 8192 + 256, CW_KMAXS = 8192 + 512, CW_KMAXC = 8192 + 1024, CW_SSQ = 16384;
constexpr int RING_BYTES = 131072, MISC_OFF = RING_BYTES + 320, LDS_BYTES = 147456;

typedef __bf16 bf16x2_t __attribute__((ext_vector_type(2)));
__device__ __forceinline__ unsigned cvt_pk_bf16(float lo, float hi) { const f32x2 v = {lo, hi}; const bf16x2_t b = __builtin_convertvector(v, bf16x2_t); return __builtin_bit_cast(unsigned, b); }
__device__ __forceinline__ float bf_lo(unsigned w) { return __uint_as_float(w << 16); }
__device__ __forceinline__ float bf_hi(unsigned w) { return __uint_as_float(w & 0xffff0000u); }
template <int CTRL> __device__ __forceinline__ float dpp_mov(float v) { return __int_as_float(__builtin_amdgcn_update_dpp(0, __float_as_int(v), CTRL, 0xF, 0xF, true)); }
__device__ __forceinline__ float row16_sum(float v) { v += dpp_mov<0xB1>(v); v += dpp_mov<0x4E>(v); v += dpp_mov<0x141>(v); v += dpp_mov<0x140>(v); return v; }
__device__ __forceinline__ float row16_max(float v) { v = fmaxf(v, dpp_mov<0xB1>(v)); v = fmaxf(v, dpp_mov<0x4E>(v)); v = fmaxf(v, dpp_mov<0x141>(v)); v = fmaxf(v, dpp_mov<0x140>(v)); return v; }
__device__ __forceinline__ float swap16_sum(float v) { auto rr = __builtin_amdgcn_permlane16_swap(__float_as_uint(v), __float_as_uint(v), false, false); return __uint_as_float(rr[0]) + __uint_as_float(rr[1]); }
__device__ __forceinline__ float swap32_sum(float v) { auto rr = __builtin_amdgcn_permlane32_swap(__float_as_uint(v), __float_as_uint(v), false, false); return __uint_as_float(rr[0]) + __uint_as_float(rr[1]); }
__device__ __forceinline__ float swap32_max(float v) { auto rr = __builtin_amdgcn_permlane32_swap(__float_as_uint(v), __float_as_uint(v), false, false); return fmaxf(__uint_as_float(rr[0]), __uint_as_float(rr[1])); }
__device__ __forceinline__ float wave_sum(float v) { return swap32_sum(swap16_sum(row16_sum(v))); }
__device__ __forceinline__ float bperm(int src_lane, float v) { return __int_as_float(__builtin_amdgcn_ds_bpermute(src_lane << 2, __float_as_int(v))); }
__device__ __forceinline__ float ex2(float x) { return __builtin_amdgcn_exp2f(x); }
__device__ __forceinline__ float lg2(float x) { return __builtin_amdgcn_logf(x); }
__device__ __forceinline__ float partner32(float v, int hi) {
    auto rr = __builtin_amdgcn_permlane32_swap(__float_as_uint(v), __float_as_uint(v), false, false);
    return __uint_as_float(hi ? rr[0] : rr[1]);
}
__device__ __forceinline__ void st16_wt(void* p, u32x4 v) { asm volatile("global_store_dwordx4 %0, %1, off sc1\n\ts_nop 1" :: "v"(p), "v"(v)); }
#define LDS_WAIT() asm volatile("s_waitcnt lgkmcnt(0)" ::: "memory")
#define VM_WAIT() asm volatile("s_waitcnt vmcnt(0)" ::: "memory")

namespace pg8 {
constexpr int BM = 256, BK = 64, HALF = 128, HTB = HALF * BK * 2, STAGE_BYTES = 8 * HTB, NXCD = 8, WGM = 8;
__host__ __device__ __forceinline__ int lds_byte(int r, int c) { const int st = (r >> 4) * 2 + (c >> 5), rr = r & 15, cc = c & 31, ob = rr * 64 + cc * 2; return st * 1024 + (ob ^ (((ob >> 9) & 1) << 5)); }
__host__ __device__ __forceinline__ void stage_rc(int b, int& R, int& C) { const int st = b / 1024, sb = b % 1024, swz = sb ^ (((sb >> 9) & 1) << 5); R = (st >> 1) * 16 + swz / 64; C = (st & 1) * 32 + (swz % 64) / 2; }
__host__ __device__ __forceinline__ int perm32(int rho) { const int n = rho >> 4, i = rho & 15; return 8 * (i >> 2) + 4 * n + (i & 3); }
struct Unit { int pm, pn; };
struct Gemm { const bf16_t* A; const bf16_t* Bt; int M, N, K; };
struct StaticOrder {
    int nM, nN, nwg, G, c, perm24;
    __host__ __device__ void init(int M, int N, int G_, int c_, int perm24_ = 0) { nM = M / BM; nN = N / BM; nwg = nM * nN; G = G_; c = c_; perm24 = perm24_; }
    __host__ __device__ bool next(int i, Unit& u) const {
        const long L = (long)i * G + c; if (L >= nwg) return false;
        int wgid = (int)L; { const int q = nwg / NXCD, r = nwg % NXCD, xcd = wgid % NXCD, off = wgid / NXCD; wgid = (xcd < r ? xcd * (q + 1) : r * (q + 1) + (xcd - r) * q) + off; }
        const int nig = WGM * nN, gid = wgid / nig, fm = gid * WGM, gsz = (nM - fm) < WGM ? (nM - fm) : WGM;
        u.pm = fm + ((wgid % nig) % gsz); u.pn = (wgid % nig) / gsz;
        if (perm24) {
            const unsigned long long LO = 0ull | (0ull << 0) | (1ull << 5) | (2ull << 10) | (3ull << 15) | (9ull << 20) | (10ull << 25) | (11ull << 30) | (12ull << 35) | (4ull << 40) | (5ull << 45) | (6ull << 50) | (7ull << 55);
            const unsigned long long HI = 0ull | (13ull << 0) | (14ull << 5) | (18ull << 10) | (19ull << 15) | (8ull << 20) | (15ull << 25) | (16ull << 30) | (17ull << 35) | (20ull << 40) | (21ull << 45) | (22ull << 50) | (23ull << 55);
            u.pn = (int)(((u.pn < 12) ? (LO >> (5 * u.pn)) : (HI >> (5 * (u.pn - 12)))) & 31ull);
        }
        return true;
    }
    __device__ __forceinline__ void a_ready(const Unit&) const {}
    __device__ __forceinline__ void done(const Unit&) const {}
};


struct EpiProj {
    static constexpr bool PERM = true, AFTER_DRAIN = false;
    bf16_t* proj; const float* ssq; float* out; int layer; unsigned* kmaxp;
    __device__ __forceinline__ void operator()(const f32x4 (&acc)[2][2][4][2], const Unit& u, int wr, int wc, int fr, int fq) const {
        const int row0 = u.pm * BM + wr * 64 + fr, col0 = u.pn * BM + wc * 32 + 8 * fq;
        int seg = -1, segcol = 0;
        if (u.pn >= 9 && u.pn < 15) { seg = (u.pn - 9) / 3; segcol = ((u.pn - 9) % 3) * 256; }
        else if (u.pn >= 18) { seg = 2 + (u.pn - 18) / 3; segcol = ((u.pn - 18) % 3) * 256; }
        const bool isfk = (u.pn >= 18 && u.pn < 21);
        float ssr[2][2][4];
#pragma unroll
        for (int ai = 0; ai < 2; ++ai)
#pragma unroll
            for (int m = 0; m < 4; ++m) {
                const int r = row0 + ai * HALF + m * 16;
                const float rs = rsqrtf(ssq[r] * (1.0f / DM) + EPS);
                bf16_t* rowp = proj + (size_t)r * NPROJ + col0;
                float* orow = nullptr; const int odd = fr & 1;
                if (seg >= 0) orow = out + O_PSBK + (size_t)seg * P_KV_STRIDE + ((size_t)layer * SEQ + (r - odd)) * 768 + segcol + wc * 32 + 8 * fq + 4 * odd;
#pragma unroll
                for (int bj = 0; bj < 2; ++bj) {
                    const f32x4 v0 = acc[ai][bj][m][0] * rs, v1 = acc[ai][bj][m][1] * rs;
                    u32x4 w; w.x = cvt_pk_bf16(v0[0], v0[1]); w.y = cvt_pk_bf16(v0[2], v0[3]); w.z = cvt_pk_bf16(v1[0], v1[1]); w.w = cvt_pk_bf16(v1[2], v1[3]);
                    *(u32x4*)(rowp + bj * HALF) = w;
                    if (seg >= 0) {
                        const f32x4 x = odd ? v0 : v1;
                        const f32x4 rc = {dpp_mov<0xB1>(x[0]), dpp_mov<0xB1>(x[1]), dpp_mov<0xB1>(x[2]), dpp_mov<0xB1>(x[3])};
                        __builtin_nontemporal_store(odd ? rc : v0, (f32x4*)(orow + bj * HALF)); __builtin_nontemporal_store(odd ? v1 : rc, (f32x4*)(orow + bj * HALF + 768)); }
                    float ss = (v0[0] * v0[0] + v0[1] * v0[1]) + (v0[2] * v0[2] + v0[3] * v0[3]) + (v1[0] * v1[0] + v1[1] * v1[1]) + (v1[2] * v1[2] + v1[3] * v1[3]);
                    ssr[bj][ai][m] = ss;
                }
            }
        if (isfk) {
#pragma unroll
            for (int bj = 0; bj < 2; ++bj) {
                const int head = 2 * (u.pn - 18) + bj;
                float pr[2][4];
#pragma unroll
                for (int ai = 0; ai < 2; ++ai)
#pragma unroll
                    for (int m = 0; m < 4; ++m) pr[ai][m] = swap32_sum(swap16_sum(ssr[bj][ai][m]));
                {
                    float mx = fmaxf(fmaxf(fmaxf(pr[0][0], pr[0][1]), fmaxf(pr[0][2], pr[0][3])), fmaxf(fmaxf(pr[1][0], pr[1][1]), fmaxf(pr[1][2], pr[1][3])));
                    mx = row16_max(mx);
                    if (fr == 0 && fq == 0) atomicMax(kmaxp + (layer * NH + head) * 4 + wc, __float_as_uint(mx));
                }
            }
        }
    }
};
template <bool BASE_F32> struct EpiRes {
    static constexpr bool PERM = true, AFTER_DRAIN = false;
    const float* base_f; bf16_t* xb; float* ssq_out;
    __device__ __forceinline__ void operator()(const f32x4 (&acc)[2][2][4][2], const Unit& u, int wr, int wc, int fr, int fq) const {
        const int row0 = u.pm * BM + wr * 64 + fr, col0 = u.pn * BM + wc * 32 + 8 * fq;
#pragma unroll
        for (int ai = 0; ai < 2; ++ai)
#pragma unroll
            for (int m = 0; m < 4; ++m) {
                const int r = row0 + ai * HALF + m * 16;
                bf16_t* bo = xb + (size_t)r * DM + col0;
                float ss = 0.f;
#pragma unroll
                for (int bj = 0; bj < 2; ++bj) {
                    f32x4 b0, b1;
                    if constexpr (BASE_F32) { const float* bp = base_f + (size_t)r * DM + col0 + bj * HALF; b0 = *(const f32x4*)bp; b1 = *(const f32x4*)(bp + 4); }
                    else { const u32x4 w = *(const u32x4*)(bo + bj * HALF); b0 = (f32x4){bf_lo(w.x), bf_hi(w.x), bf_lo(w.y), bf_hi(w.y)}; b1 = (f32x4){bf_lo(w.z), bf_hi(w.z), bf_lo(w.w), bf_hi(w.w)}; }
                    const f32x4 v0 = b0 + acc[ai][bj][m][0], v1 = b1 + acc[ai][bj][m][1];
                    u32x4 w; w.x = cvt_pk_bf16(v0[0], v0[1]); w.y = cvt_pk_bf16(v0[2], v0[3]); w.z = cvt_pk_bf16(v1[0], v1[1]); w.w = cvt_pk_bf16(v1[2], v1[3]);
                    st16_wt(bo + bj * HALF, w);
                    ss += (v0[0] * v0[0] + v0[1] * v0[1]) + (v0[2] * v0[2] + v0[3] * v0[3]) + (v1[0] * v1[0] + v1[1] * v1[1]) + (v1[2] * v1[2] + v1[3] * v1[3]);
                }
                ss = swap32_sum(swap16_sum(ss));
                if (fq == 0) atomicAdd(ssq_out + r, ss);
            }
    }
};
struct EpiGU {
    static constexpr bool PERM = true, AFTER_DRAIN = false;
    bf16_t* h; const float* ssq;
    __device__ __forceinline__ void operator()(const f32x4 (&acc)[2][2][4][2], const Unit& u, int wr, int wc, int fr, int fq) const {
        const int row0 = u.pm * BM + wr * 64 + fr, col0 = u.pn * HALF + wc * 32 + 8 * fq;
#pragma unroll
        for (int ai = 0; ai < 2; ++ai)
#pragma unroll
            for (int m = 0; m < 4; ++m) {
                const int r = row0 + ai * HALF + m * 16;
                const float rs = rsqrtf(ssq[r] * (1.0f / DM) + EPS);
                float o[8];
#pragma unroll
                for (int n = 0; n < 2; ++n)
#pragma unroll
                    for (int i = 0; i < 4; ++i) {
                        const float g = acc[ai][0][m][n][i] * rs, up = acc[ai][1][m][n][i] * rs;
                        o[4 * n + i] = g * up * __builtin_amdgcn_rcpf(1.0f + ex2(-g * LOG2E));
                    }
                u32x4 w; w.x = cvt_pk_bf16(o[0], o[1]); w.y = cvt_pk_bf16(o[2], o[3]); w.z = cvt_pk_bf16(o[4], o[5]); w.w = cvt_pk_bf16(o[6], o[7]);
                *(u32x4*)(h + (size_t)r * DFF + col0) = w;
            }
    }
};

template <class Epi, class Sched, bool ALIGN_EPI = false, bool SP2 = false>
__device__ __forceinline__ void gemm_phase(LAS unsigned char* lds, const Gemm g, const Sched& S, const Epi& E) {
    int tid = threadIdx.x; asm volatile("" : "+v"(tid));
    const int wid = __builtin_amdgcn_readfirstlane(tid >> 6), lane = tid & 63, wr = wid >> 2, wc = wid & 3, fr = lane & 15, fq = lane >> 4;
    const int K = g.K, nt = K / BK;
    unsigned voffA[2], voffB[2];
#pragma unroll
    for (int i = 0; i < 2; ++i) { int R, C; stage_rc(tid * 16 + i * 8192, R, C); const int Rb = Epi::PERM ? ((R & ~31) + perm32(R & 31)) : R;
        voffA[i] = (unsigned)(R * K + C) * 2u; voffB[i] = (unsigned)(Rb * K + C) * 2u; }
    const size_t kstep = (size_t)(BK * 2);
    const size_t hstep = (size_t)HALF * K * 2;
    const size_t tstep = 2 * hstep;
    const unsigned ldsw = (unsigned)wid * 1024u;
    const int aoff = lds_byte(wr * 64 + fr, fq * 8), boff = lds_byte(wc * 32 + fr, fq * 8);
#define PG8_SA(b, h) (((b) * 2 + (h)) * HTB)
#define PG8_SB(b, h) ((4 + (b) * 2 + (h)) * HTB)
#define PG8_STAGE(bufoff, gbase, voff) do { _Pragma("unroll") for (int _i = 0; _i < 2; ++_i) \
        __builtin_amdgcn_global_load_lds((const unsigned*)((const char*)(gbase) + (voff)[_i]), (LAS unsigned*)(lds + (bufoff) + ldsw + _i * 8192), 16, 0, 0); } while (0)
#define PG8_LDA(dst, b, h) do { _Pragma("unroll") for (int m = 0; m < 4; ++m) _Pragma("unroll") for (int k = 0; k < 2; ++k) dst[m][k] = *(const LAS bf16x8*)(lds + PG8_SA(b, h) + aoff + m * 2048 + k * 1024); } while (0)
#define PG8_LDB(dst, b, h) do { _Pragma("unroll") for (int n = 0; n < 2; ++n) _Pragma("unroll") for (int k = 0; k < 2; ++k) dst[n][k] = *(const LAS bf16x8*)(lds + PG8_SB(b, h) + boff + n * 2048 + k * 1024); } while (0)
#define PG8_MMA(ai, bj, At, Bt) do { __builtin_amdgcn_s_setprio(1); _Pragma("unroll") for (int m = 0; m < 4; ++m) _Pragma("unroll") for (int n = 0; n < 2; ++n) _Pragma("unroll") for (int k = 0; k < 2; ++k) \
        acc[ai][bj][m][n] = __builtin_amdgcn_mfma_f32_16x16x32_bf16(Bt[n][k], At[m][k], acc[ai][bj][m][n], 0, 0, 0); __builtin_amdgcn_s_setprio(0); } while (0)
#define PG8_WAIT_V(n) asm volatile("s_waitcnt vmcnt(" #n ")" ::: "memory")
#define PG8_WAIT_L(n) asm volatile("s_waitcnt lgkmcnt(" #n ")" ::: "memory")
#define PG8_BAR __builtin_amdgcn_s_barrier()
#define PG8_SCHED __builtin_amdgcn_sched_barrier(0)
    Unit cur, nxt; int ui = 0;
    if (!S.next(0, cur)) return;
    f32x4 acc[2][2][4][2];
#pragma unroll
    for (int a = 0; a < 2; ++a)
#pragma unroll
        for (int b = 0; b < 2; ++b)
#pragma unroll
            for (int m = 0; m < 4; ++m)
#pragma unroll
                for (int n = 0; n < 2; ++n) acc[a][b][m][n] = (f32x4){0.f, 0.f, 0.f, 0.f};
    bf16x8 At[4][2], B0[2][2], B1[2][2];
    const char* cA = (const char*)g.A + (size_t)cur.pm * tstep; const char* cB = (const char*)g.Bt + (size_t)cur.pn * tstep;
    S.a_ready(cur);
    if constexpr (SP2) {
        PG8_STAGE(PG8_SB(0, 0), cB, voffB); PG8_STAGE(PG8_SB(0, 1), cB + hstep, voffB); PG8_STAGE(PG8_SA(0, 0), cA, voffA); PG8_STAGE(PG8_SA(0, 1), cA + hstep, voffA);
        if (wr == 1) PG8_BAR;
        PG8_WAIT_V(2); PG8_BAR;
        PG8_STAGE(PG8_SB(1, 0), cB + kstep, voffB); PG8_STAGE(PG8_SA(1, 0), cA + kstep, voffA); PG8_STAGE(PG8_SB(1, 1), cB + hstep + kstep, voffB);
        PG8_WAIT_V(6); PG8_BAR;
    } else {
        PG8_STAGE(PG8_SB(0, 0), cB, voffB); PG8_STAGE(PG8_SA(0, 0), cA, voffA); PG8_STAGE(PG8_SB(0, 1), cB + hstep, voffB); PG8_STAGE(PG8_SA(0, 1), cA + hstep, voffA);
        if (wr == 1) PG8_BAR;
        PG8_WAIT_V(4); PG8_BAR;
        PG8_STAGE(PG8_SB(1, 0), cB + kstep, voffB); PG8_STAGE(PG8_SA(1, 0), cA + kstep, voffA); PG8_STAGE(PG8_SB(1, 1), cB + hstep + kstep, voffB);
        PG8_WAIT_V(6); PG8_BAR;
    }
    for (;;) {
        const bool has_next = S.next(ui + 1, nxt);
        const char* nA = has_next ? (const char*)g.A + (size_t)nxt.pm * tstep : cA; const char* nB = has_next ? (const char*)g.Bt + (size_t)nxt.pn * tstep : cB;
        for (int t = 0; t < nt; t += 2) {
            const bool last = (t == nt - 2);
            const char* a1 = cA + (size_t)(t + 1) * kstep;
            const char* a2 = last ? nA : cA + (size_t)(t + 2) * kstep; const char* b2 = last ? nB : cB + (size_t)(t + 2) * kstep;
            const char* a3 = a2 + kstep; const char* b3 = b2 + kstep;
            if (last && has_next) S.a_ready(nxt);
            if constexpr (SP2) {
            PG8_LDB(B0, 0, 0); PG8_LDB(B1, 0, 1); PG8_SCHED; PG8_LDA(At, 0, 0); PG8_STAGE(PG8_SA(1, 1), a1 + hstep, voffA);
            PG8_WAIT_V(8); PG8_WAIT_L(0); PG8_BAR; PG8_MMA(0, 0, At, B0); PG8_MMA(0, 1, At, B1); PG8_BAR; PG8_SCHED;
            PG8_LDA(At, 0, 1); PG8_STAGE(PG8_SB(0, 0), b2, voffB); PG8_STAGE(PG8_SB(0, 1), b2 + hstep, voffB); PG8_STAGE(PG8_SA(0, 0), a2, voffA);
            PG8_WAIT_V(8); PG8_WAIT_L(0); PG8_BAR; PG8_MMA(1, 0, At, B0); PG8_MMA(1, 1, At, B1); PG8_BAR; PG8_SCHED;
            PG8_LDB(B0, 1, 0); PG8_LDB(B1, 1, 1); PG8_SCHED; PG8_LDA(At, 1, 0); PG8_STAGE(PG8_SA(0, 1), a2 + hstep, voffA);
            PG8_WAIT_V(8); PG8_WAIT_L(0); PG8_BAR; PG8_MMA(0, 0, At, B0); PG8_MMA(0, 1, At, B1); PG8_BAR; PG8_SCHED;
            PG8_LDA(At, 1, 1); PG8_STAGE(PG8_SB(1, 0), b3, voffB); PG8_STAGE(PG8_SB(1, 1), b3 + hstep, voffB); PG8_STAGE(PG8_SA(1, 0), a3, voffA);
            PG8_WAIT_V(8); PG8_WAIT_L(0); PG8_BAR; PG8_MMA(1, 0, At, B0); PG8_MMA(1, 1, At, B1); PG8_BAR; PG8_SCHED;
            } else {
            PG8_LDB(B0, 0, 0); PG8_SCHED; PG8_LDA(At, 0, 0); PG8_STAGE(PG8_SA(1, 1), a1 + hstep, voffA);
            PG8_WAIT_L(8); PG8_BAR; PG8_WAIT_L(0); PG8_MMA(0, 0, At, B0); PG8_BAR; PG8_SCHED;
            PG8_LDB(B1, 0, 1); PG8_STAGE(PG8_SB(0, 0), b2, voffB);
            PG8_BAR; PG8_WAIT_L(0); PG8_MMA(0, 1, At, B1); PG8_BAR;
            PG8_LDA(At, 0, 1); PG8_STAGE(PG8_SA(0, 0), a2, voffA);
            PG8_BAR; PG8_WAIT_L(0); PG8_MMA(1, 0, At, B0); PG8_BAR; PG8_SCHED;
            PG8_STAGE(PG8_SB(0, 1), b2 + hstep, voffB);
            PG8_WAIT_V(6); PG8_BAR; PG8_MMA(1, 1, At, B1); PG8_BAR;
            PG8_LDB(B0, 1, 0); PG8_SCHED; PG8_LDA(At, 1, 0); PG8_STAGE(PG8_SA(0, 1), a2 + hstep, voffA);
            PG8_WAIT_L(8); PG8_BAR; PG8_WAIT_L(0); PG8_MMA(0, 0, At, B0); PG8_BAR; PG8_SCHED;
            PG8_LDB(B1, 1, 1); PG8_STAGE(PG8_SB(1, 0), b3, voffB);
            PG8_BAR; PG8_WAIT_L(0); PG8_MMA(0, 1, At, B1); PG8_BAR;
            PG8_LDA(At, 1, 1); PG8_STAGE(PG8_SA(1, 0), a3, voffA);
            PG8_BAR; PG8_WAIT_L(0); PG8_MMA(1, 0, At, B0); PG8_BAR; PG8_SCHED;
            PG8_STAGE(PG8_SB(1, 1), b3 + hstep, voffB);
            PG8_WAIT_V(6); PG8_BAR; PG8_MMA(1, 1, At, B1); PG8_BAR;
            }
        }
        if constexpr (ALIGN_EPI) { if (wr == 0) PG8_BAR; }
        if constexpr (!Epi::AFTER_DRAIN) { E(acc, cur, wr, wc, fr, fq); S.done(cur); }
        if (!has_next) break;
#pragma unroll
        for (int a = 0; a < 2; ++a)
#pragma unroll
            for (int b = 0; b < 2; ++b)
#pragma unroll
                for (int m = 0; m < 4; ++m)
#pragma unroll
                    for (int n = 0; n < 2; ++n) acc[a][b][m][n] = (f32x4){0.f, 0.f, 0.f, 0.f};
        cur = nxt; cA = nA; cB = nB; ++ui;
        if constexpr (ALIGN_EPI) { if (wr == 1) PG8_BAR; }
    }
    PG8_WAIT_V(0);
    if constexpr (!ALIGN_EPI) { if (wr == 0) PG8_BAR; }
    PG8_BAR;
#undef PG8_SA
#undef PG8_SB
#undef PG8_STAGE
#undef PG8_LDA
#undef PG8_LDB
#undef PG8_MMA
#undef PG8_WAIT_V
#undef PG8_WAIT_L
#undef PG8_BAR
#undef PG8_SCHED
}
}

#define XB_TMO      128
#define XB_XCNT(j)  (256  + 64 * (j))
#define XB_XSUB(j)  (1280 + 64 * (j))
#define XB_XGEN(j)  (2304 + 64 * (j))
#define XB_TOP      3328
#define XB_TOPGEN   3392
#define XCD_BAR_WORDS 3456
#define XB_SPIN_CAP (1u << 18)
__device__ __forceinline__ unsigned xb_ld(unsigned* p)              { return __hip_atomic_load(p, __ATOMIC_RELAXED, __HIP_MEMORY_SCOPE_AGENT); }
__device__ __forceinline__ unsigned xb_add(unsigned* p, unsigned v) { return __hip_atomic_fetch_add(p, v, __ATOMIC_RELAXED, __HIP_MEMORY_SCOPE_AGENT); }
__device__ __forceinline__ unsigned xb_xcc_id() { return (unsigned)__builtin_amdgcn_s_getreg((3 << 11) | 20) & 0xFu; }
#define XB_SPIN(cond, bar) do { unsigned _sp = 0; while (cond) { __builtin_amdgcn_s_sleep(1); \
    if ((++_sp & 255u) == 0u) { if (xb_ld(&(bar)[XB_TMO])) break; if (_sp > XB_SPIN_CAP) { atomicAdd(&(bar)[XB_TMO], 1u); break; } } } } while (0)
struct XcdBarrier { unsigned* bar; unsigned x; volatile LAS unsigned* st; };
__device__ __forceinline__ XcdBarrier xcd_barrier_post(unsigned* bar, volatile LAS unsigned* st) {
    XcdBarrier b; b.bar = bar; b.x = xb_xcc_id(); b.st = st;
    if (threadIdx.x == 0) (void)xb_add(&bar[XB_XCNT(b.x)], 1u);
    return b;
}
__device__ __forceinline__ void xcd_barrier_complete(unsigned* bar, unsigned x, unsigned& nloc, unsigned& nx) {
    const unsigned G = gridDim.x * gridDim.y * gridDim.z;
    unsigned sum, cnt, mine, sp = 0u;
    for (;;) {
        sum = 0u; cnt = 0u; mine = 0u;
#pragma unroll
        for (unsigned j = 0; j < 16; ++j) { const unsigned c = xb_ld(&bar[XB_XCNT(j)]); sum += c; cnt += (c > 0u) ? 1u : 0u; mine = (j == x) ? c : mine; }
        if (sum == G) break;
        __builtin_amdgcn_s_sleep(1);
        if ((++sp & 255u) == 0u) { if (xb_ld(&bar[XB_TMO])) break; if (sp > XB_SPIN_CAP) { atomicAdd(&bar[XB_TMO], 1u); break; } }
    }
    nloc = mine > 0u ? mine : 1u; nx = cnt > 0u ? cnt : 1u;
}
__device__ __forceinline__ void xcd_barrier(const XcdBarrier& b) {
    asm volatile("s_waitcnt vmcnt(0)" ::: "memory");
    __syncthreads();
    if (threadIdx.x == 0) {
        long zb_ = 0; asm volatile("" : "+s"(zb_)); unsigned* bar = b.bar + zb_;
        unsigned bx_ = b.x; asm volatile("" : "+s"(bx_));
        __builtin_amdgcn_s_waitcnt(0);
        unsigned nloc = b.st[0], nx = b.st[1];
        if (nloc == 0u) { xcd_barrier_complete(bar, bx_, nloc, nx); b.st[0] = nloc; b.st[1] = nx; }
        const unsigned old = xb_add(&bar[XB_XSUB(bx_)], 1u);
        const unsigned gen = old / nloc;
        if (old + 1u == (gen + 1u) * nloc) {
            __builtin_amdgcn_fence(__ATOMIC_RELEASE, "agent");
            asm volatile("s_waitcnt vmcnt(0)" ::: "memory");
            const unsigned og = xb_add(&bar[XB_TOP], 1u);
            const unsigned tg = og / nx;
            if (og + 1u == (tg + 1u) * nx) xb_add(&bar[XB_TOPGEN], 1u);
            else XB_SPIN(xb_ld(&bar[XB_TOPGEN]) == tg, bar);
            __builtin_amdgcn_fence(__ATOMIC_ACQUIRE, "agent");
            xb_add(&bar[XB_XGEN(bx_)], 1u);
            asm volatile("s_waitcnt vmcnt(0)" ::: "memory");
        } else {
            XB_SPIN(xb_ld(&bar[XB_XGEN(bx_)]) == gen, bar);
            __builtin_amdgcn_fence(__ATOMIC_ACQUIRE, "agent");
            asm volatile("s_waitcnt vmcnt(0)" ::: "memory");
        }
    }
    __syncthreads();
}

#define KSWZ(row, colB) ((row) * 256 + ((colB) ^ (((row) & 7) << 4)))
#define SBAR() __builtin_amdgcn_sched_barrier(0)
__device__ __forceinline__ int crow(int r, int hi) { return (r & 3) + 8 * (r >> 2) + 4 * hi; }
__device__ __forceinline__ int v_st(int k, int c) { const int kk = (k & ~0xC) | ((k & 4) << 1) | ((k & 8) >> 1); return ((kk >> 3) * 4 + (c >> 5)) * 512 + ((kk & 7) * 32 + (c & 31)) * 2; }
__device__ __forceinline__ int v_rd_base(int lane) { return ((lane & 3) << 3) | (((lane >> 2) & 3) << 6) | (((lane >> 4) & 1) << 5) | (((lane >> 5) & 1) << 8); }
constexpr int v_rd_off(int d0, int ks, int half) { return d0 * 512 + ks * 4096 + half * 2048; }
template <int OFF> __device__ __forceinline__ s16x4 tr_read(unsigned vb) {
    s16x4 r; asm volatile("ds_read_b64_tr_b16 %0, %1 offset:%2" : "=&v"(r) : "v"(vb), "i"(OFF) : "memory"); return r;
}
template <int D0> __device__ __forceinline__ void pv_one(f32x16& od, unsigned vb, bf16x8 pa0, bf16x8 pa1, bf16x8 pa2, bf16x8 pa3) {
    const s16x4 l0 = tr_read<v_rd_off(D0, 0, 0)>(vb), h0 = tr_read<v_rd_off(D0, 0, 1)>(vb), l1 = tr_read<v_rd_off(D0, 1, 0)>(vb), h1 = tr_read<v_rd_off(D0, 1, 1)>(vb);
    const s16x4 l2 = tr_read<v_rd_off(D0, 2, 0)>(vb), h2 = tr_read<v_rd_off(D0, 2, 1)>(vb), l3 = tr_read<v_rd_off(D0, 3, 0)>(vb), h3 = tr_read<v_rd_off(D0, 3, 1)>(vb);
    asm volatile("s_waitcnt lgkmcnt(0)" ::: "memory"); SBAR();
#define PK(L, H) (bf16x8){L[0], L[1], L[2], L[3], H[0], H[1], H[2], H[3]}
    od = __builtin_amdgcn_mfma_f32_32x32x16_bf16(pa0, PK(l0, h0), od, 0, 0, 0);
    od = __builtin_amdgcn_mfma_f32_32x32x16_bf16(pa1, PK(l1, h1), od, 0, 0, 0);
    od = __builtin_amdgcn_mfma_f32_32x32x16_bf16(pa2, PK(l2, h2), od, 0, 0, 0);
    od = __builtin_amdgcn_mfma_f32_32x32x16_bf16(pa3, PK(l3, h3), od, 0, 0, 0);
#undef PK
}
#define PK4(P, BASE, OUT) do { unsigned a0 = cvt_pk_bf16(P[BASE + 0], P[BASE + 1]), a1 = cvt_pk_bf16(P[BASE + 2], P[BASE + 3]);   \
    unsigned b0 = cvt_pk_bf16(P[BASE + 4], P[BASE + 5]), b1 = cvt_pk_bf16(P[BASE + 6], P[BASE + 7]);                              \
    auto r0 = __builtin_amdgcn_permlane32_swap(a0, b0, false, false); auto r1 = __builtin_amdgcn_permlane32_swap(a1, b1, false, false); \
    u32x4 w = {r0[0], r1[0], r0[1], r1[1]}; OUT = __builtin_bit_cast(bf16x8, w); } while (0)

constexpr int AL_KV = 0  , AL_WS = 65536  , AL_CQ = 67584  , AL_CK = 69632  ,
              AL_FLAG = 70656  , AL_Q = 73728  , AL_Q7 = 135168;

struct AttnItem {
    int sb;
    int nq, t0, Kc, Knew_cnt;
    const bf16_t* Q;
    const float* Kcache; const float* Vcache;
    const bf16_t* Knew; const bf16_t* Vnew;
    const float* Lcache; const float* Lnew;
    float kn2, kn2b;
    bf16_t* O;
};

__device__ __forceinline__ bf16x8 cvt8(const f32x4 a, const f32x4 b) {
    u32x4 w = {cvt_pk_bf16(a[0], a[1]), cvt_pk_bf16(a[2], a[3]), cvt_pk_bf16(b[0], b[1]), cvt_pk_bf16(b[2], b[3])}; return __builtin_bit_cast(bf16x8, w);
}
template <int SB> __device__ __forceinline__ void attn_item(const AttnItem& it, LAS unsigned char* lds) {
    int tid = threadIdx.x; asm volatile("" : "+v"(tid));
    const int lane = tid & 63, r32 = lane & 31, hi = lane >> 5; const int wid = __builtin_amdgcn_readfirstlane(tid >> 6);
    const int hs = wid >> 2, rg = wid & 3;
    LAS unsigned char* K_lds = lds + AL_KV + hs * 32768; LAS unsigned char* V_lds = K_lds + 16384;
    LAS float* wsf = (LAS float*)(lds + AL_WS) + wid * 64;
    LAS float* cq_l = (LAS float*)(lds + AL_CQ) + hs * 256; LAS float* ck_l = (LAS float*)(lds + AL_CK) + hs * 128; volatile LAS unsigned* flag_l = (volatile LAS unsigned*)(lds + AL_FLAG);
    const bool active = (32 * rg < it.nq);
    constexpr int sb = SB;
    LAS unsigned char* Q_lds = lds + (wid == 7 ? AL_Q7 : AL_Q + wid * 8192);
    const float* Lnew_h = it.Lnew + hs; const float* Lcache_h = it.Lcache + hs;
    float qn = 0.f, cq = 0.f;
    if (active) {
        const bf16_t* Qw = it.Q + (size_t)(32 * rg + r32) * NPROJ + hs * HD + hi * 8;
        float s2 = 0.f;
#pragma unroll
        for (int d0 = 0; d0 < 8; ++d0) { const bf16x8 qv = *(const bf16x8*)(Qw + d0 * 16);
            *(LAS bf16x8*)(Q_lds + KSWZ(r32, (d0 * 16 + hi * 8) * 2)) = qv;
            const u32x4 w = __builtin_bit_cast(u32x4, qv);
#pragma unroll
            for (int i = 0; i < 4; ++i) { const float a = bf_lo(w[i]), b = bf_hi(w[i]); s2 += a * a + b * b; } }
        s2 += partner32(s2, hi);
        qn = sqrtf(s2);
    }
    if (!sb) {
        if (rg == 3) {
            float v[4]; float s = 0.f;
#pragma unroll
            for (int i = 0; i < 4; ++i) { const int idx = 4 * lane + i; const int pn = it.t0 - it.Kc + idx; v[i] = (idx < it.nq) ? Lnew_h[(size_t)pn * 6] : 0.f; s += v[i]; }
            float incl = s;
#pragma unroll
            for (int o = 1; o < 64; o <<= 1) { const float t = bperm((lane - o) & 63, incl); if (lane >= o) incl += t; }
            float run = incl - s;
#pragma unroll
            for (int i = 0; i < 4; ++i) { run += v[i]; cq_l[4 * lane + i] = run; }
        }
        __syncthreads();
        cq = cq_l[32 * rg + r32];
    }
    const float knorm = sqrtf(hs ? it.kn2b : it.kn2) * 1.01f;
    float R = 0.f, m_run = -1e30f, l_run = 0.f, tot = 0.f;
    f32x16 o[4];
#pragma unroll
    for (int d = 0; d < 4; ++d) o[d] = f32x16{};
    bool done = !active;
    const int qpos = it.t0 + 32 * rg + r32, qpos_max = it.t0 + 32 * rg + 31;
    const int sr = (tid & 255) >> 4, sc = (tid & 15) * 8;
    const unsigned vb = (unsigned)(uintptr_t)V_lds + (unsigned)v_rd_base(lane);
    const int jstart = (it.t0 + it.nq - 1) >> 6;
    f32x4 ra[4];
    const f32x4 zero4 = {0.f, 0.f, 0.f, 0.f};
    const int kst = KSWZ(sr, sc * 2), vst = v_st(sr, sc);
    const int lrow = lane >> 4, lch = lane & 15;
#define NTL(p) __builtin_nontemporal_load((const f32x4*)(p))
#define V_PRELOAD(jj) do { const int j_ = (jj); \
        if (64 * j_ >= it.Kc) { \
            const int pn0_ = 64 * j_ - it.Kc; const unsigned off_ = (unsigned)(pn0_ + sr) * (unsigned)(NPROJ * 2) + (unsigned)(sc + hs * HD) * 2u; const char* vn_ = (const char*)it.Vnew; \
            ra[0] = zero4; ra[1] = zero4; ra[2] = zero4; ra[3] = zero4; \
            if (pn0_ < it.Knew_cnt) { ra[0] = *(const f32x4*)(vn_ + off_); ra[1] = *(const f32x4*)(vn_ + 16 * NPROJ * 2 + off_); } \
            if (pn0_ + 32 < it.Knew_cnt) { ra[2] = *(const f32x4*)(vn_ + 32 * NPROJ * 2 + off_); ra[3] = *(const f32x4*)(vn_ + 48 * NPROJ * 2 + off_); } } } while (0)
#define K_STAGE(jj) do { const int j_ = (jj); \
        if (64 * j_ >= it.Kc && 64 * j_ - it.Kc + 64 <= it.Knew_cnt) {     \
            const char* kn_ = (const char*)it.Knew + ((size_t)(64 * j_ - it.Kc + 16 * rg) * NPROJ + hs * HD) * 2; LAS unsigned char* kd_ = K_lds + rg * 4096; \
            const unsigned oe_ = (unsigned)lrow * (unsigned)(NPROJ * 2) + (unsigned)((lch ^ lrow) * 16), oo_ = (unsigned)(lrow + 4) * (unsigned)(NPROJ * 2) + (unsigned)((lch ^ (lrow + 4)) * 16); \
            __builtin_amdgcn_global_load_lds((const unsigned*)(kn_ + oe_), (LAS unsigned*)(kd_), 16, 0, 0); \
            __builtin_amdgcn_global_load_lds((const unsigned*)(kn_ + oo_), (LAS unsigned*)(kd_ + 1024), 16, 0, 0); \
            __builtin_amdgcn_global_load_lds((const unsigned*)(kn_ + 8 * NPROJ * 2 + oe_), (LAS unsigned*)(kd_ + 2048), 16, 0, 0); \
            __builtin_amdgcn_global_load_lds((const unsigned*)(kn_ + 8 * NPROJ * 2 + oo_), (LAS unsigned*)(kd_ + 3072), 16, 0, 0); \
        } else if (64 * j_ < it.Kc) { \
            const char* kc_ = (const char*)it.Kcache; \
            _Pragma("unroll 1") for (int q_ = 0; q_ < 4; ++q_) { const unsigned off_ = (unsigned)(64 * j_ + sr + 16 * q_) * 3072u + (unsigned)(sc + hs * HD) * 4u; \
                const f32x4 a0_ = NTL(kc_ + off_), a1_ = NTL(kc_ + off_ + 16); *(LAS bf16x8*)(K_lds + kst + q_ * 4096) = cvt8(a0_, a1_); } \
        } else { \
            const int pn0_ = 64 * j_ - it.Kc; const unsigned off_ = (unsigned)(pn0_ + sr) * (unsigned)(NPROJ * 2) + (unsigned)(sc + hs * HD) * 2u; const char* kn_ = (const char*)it.Knew; \
            _Pragma("unroll 1") for (int q_ = 0; q_ < 4; ++q_) { f32x4 t_ = zero4; if (pn0_ + 32 * (q_ >> 1) < it.Knew_cnt) t_ = *(const f32x4*)(kn_ + q_ * 16 * NPROJ * 2 + off_); \
                *(LAS bf16x8*)(K_lds + kst + q_ * 4096) = __builtin_bit_cast(bf16x8, t_); } \
        } } while (0)
    K_STAGE(jstart); V_PRELOAD(jstart);
    for (int j = jstart; j >= 0; --j) {
        if (64 * j < it.Kc) {
            const char* vc = (const char*)it.Vcache;
#pragma unroll 1
            for (int q = 0; q < 4; ++q) {
                const unsigned off = (unsigned)(64 * j + sr + 16 * q) * 3072u + (unsigned)(sc + hs * HD) * 4u;
                const f32x4 c0 = NTL(vc + off), c1 = NTL(vc + off + 16);
                *(LAS bf16x8*)(V_lds + vst + q * 4096) = cvt8(c0, c1);
            }
        } else {
#pragma unroll
            for (int q = 0; q < 4; ++q) *(LAS bf16x8*)(V_lds + vst + q * 4096) = __builtin_bit_cast(bf16x8, ra[q]);
        }
        if (!sb && rg == 3) {
            const int p = 64 * j + lane;
            if (64 * j >= it.t0) {
                const int idx = p - it.t0;
                ck_l[lane] = (idx < it.nq) ? cq_l[idx] : 0.f;
                if (lane == 0) ck_l[64] = (64 * j > it.t0) ? cq_l[64 * j - 1 - it.t0] : 0.f;
            } else {
                float L;
                if (p < it.Kc) L = Lcache_h[(size_t)p * 6]; else L = Lnew_h[(size_t)(p - it.Kc) * 6];
                float suf = L;
#pragma unroll
                for (int o = 1; o < 64; o <<= 1) { const float t = bperm((lane + o) & 63, suf); if (lane + o < 64) suf += t; }
                ck_l[lane] = tot - (suf - L);
                const float total = __builtin_amdgcn_readfirstlane(suf);
                tot -= total;
                if (lane == 0) ck_l[64] = tot;
            }
        }
        VM_WAIT(); __syncthreads();
        if (j > 0) V_PRELOAD(j - 1);
        const bool comp = !done && 64 * j <= qpos_max;
        f32x16 p0 = f32x16{}, p1 = f32x16{};
        if (comp) {
            const int swz = (r32 & 7) << 4;
#pragma unroll
            for (int d = 0; d < 4; ++d) { const int ka = r32 * 256 + ((d * 32 + hi * 16) ^ swz);
#pragma unroll
                for (int dh = 0; dh < 2; ++dh) {
                    const bf16x8 b0 = *(const LAS bf16x8*)(K_lds + ka + dh * 128);
                    const bf16x8 b1 = *(const LAS bf16x8*)(K_lds + ka + dh * 128 + 8192);
                    const bf16x8 qf = *(const LAS bf16x8*)(Q_lds + ka + dh * 128);
                    p0 = __builtin_amdgcn_mfma_f32_32x32x16_bf16(b0, qf, p0, 0, 0, 0);
                    p1 = __builtin_amdgcn_mfma_f32_32x32x16_bf16(b1, qf, p1, 0, 0, 0); } }
        }
        __syncthreads();
        if (j > 0) K_STAGE(j - 1);
        if (comp) {
            const int kb = 64 * j + 4 * hi;
            bf16x8 pa0, pa1, pa2, pa3;
            if (sb) {
                float run = R;
#define SB_GROUP(P, g, KOFF, BAR) do { float z_[4], l_[4]; \
                    _Pragma("unroll") for (int i_ = 0; i_ < 4; ++i_) { const float z = P[4 * (g) + i_] * QK_SCALE; const float sp = lg2(1.f + ex2(-fabsf(z) * LOG2E)) * LN2; \
                        const bool ok = (kb + (KOFF) + 8 * (g) + i_) < qpos; l_[i_] = ok ? -(fmaxf(z, 0.f) + sp) : 0.f; z_[i_] = ok ? z : -INFINITY; } \
                    const float gs = (l_[0] + l_[1]) + (l_[2] + l_[3]); const float gp = partner32(gs, hi); \
                    float lat = run + (hi ? 0.f : gp); \
                    P[4 * (g) + 3] = ex2((z_[3] + l_[3] + lat) * LOG2E); lat += l_[3]; \
                    P[4 * (g) + 2] = ex2((z_[2] + l_[2] + lat) * LOG2E); lat += l_[2]; \
                    P[4 * (g) + 1] = ex2((z_[1] + l_[1] + lat) * LOG2E); lat += l_[1]; \
                    P[4 * (g) + 0] = ex2((z_[0] + l_[0] + lat) * LOG2E); \
                    run += gs + gp; if (BAR) SBAR(); } while (0)
                SB_GROUP(p1, 3, 32, 0); SB_GROUP(p1, 2, 32, 1); SB_GROUP(p1, 1, 32, 0); SB_GROUP(p1, 0, 32, 1);
                SB_GROUP(p0, 3, 0, 0); SB_GROUP(p0, 2, 0, 1); SB_GROUP(p0, 1, 0, 0); SB_GROUP(p0, 0, 0, 1);
#undef SB_GROUP
                R = run;
                PK4(p0, 0, pa0); PK4(p0, 8, pa1); PK4(p1, 0, pa2); PK4(p1, 8, pa3);
                done = __all(R < -EXIT_T);
            } else {
                float pmax = -INFINITY;
#pragma unroll
                for (int g = 0; g < 4; ++g) {
                    const f32x4 c0 = *(const LAS f32x4*)(ck_l + 8 * g + 4 * hi), c1 = *(const LAS f32x4*)(ck_l + 32 + 8 * g + 4 * hi);
#pragma unroll
                    for (int i = 0; i < 4; ++i) { const int r = 4 * g + i; const int kp = kb + i + 8 * g;
                        const float s0 = p0[r] * QK_SCALE + (cq - c0[i]), s1 = p1[r] * QK_SCALE + (cq - c1[i]);
                        p0[r] = (kp <= qpos) ? s0 : -INFINITY; p1[r] = (kp + 32 <= qpos) ? s1 : -INFINITY;
                        pmax = fmaxf(pmax, fmaxf(p0[r], p1[r])); }
                    SBAR();
                }
                pmax = fmaxf(pmax, partner32(pmax, hi));
                const float mnew = fmaxf(m_run, pmax);
                const float alpha = ex2((m_run - mnew) * LOG2E);
                float ps = 0.f;
#pragma unroll
                for (int r = 0; r < 16; ++r) { p0[r] = ex2((p0[r] - mnew) * LOG2E); p1[r] = ex2((p1[r] - mnew) * LOG2E); ps += p0[r] + p1[r]; if ((r & 3) == 3) SBAR(); }
                ps += partner32(ps, hi);
                l_run = l_run * alpha + ps; m_run = mnew;
                if (__any(alpha != 1.f)) {
                    if (hi == 0) wsf[r32] = alpha;
                    LDS_WAIT();
#pragma unroll
                    for (int r = 0; r < 16; ++r) { const float a = wsf[crow(r, hi)];
#pragma unroll
                        for (int d = 0; d < 4; ++d) o[d][r] *= a; }
                }
                PK4(p0, 0, pa0); PK4(p0, 8, pa1); PK4(p1, 0, pa2); PK4(p1, 8, pa3);
                const float zb = qn * knorm * QK_SCALE + (cq - ck_l[64]);
                done = __all(zb - m_run < -EXIT_T);
            }
            pv_one<0>(o[0], vb, pa0, pa1, pa2, pa3); pv_one<1>(o[1], vb, pa0, pa1, pa2, pa3); pv_one<2>(o[2], vb, pa0, pa1, pa2, pa3); pv_one<3>(o[3], vb, pa0, pa1, pa2, pa3);
        }
        if (lane == 0) flag_l[wid] = done ? 1u : 0u;
        __syncthreads();
        unsigned all = 1u;
#pragma unroll
        for (int w = 0; w < 8; ++w) all &= flag_l[w];
        if (all) break;
    }
    if (active) {
        float rli[16];
        if (!sb) {
            if (hi == 0) wsf[32 + r32] = 1.0f / l_run;
            LDS_WAIT();
#pragma unroll
            for (int r = 0; r < 16; ++r) rli[r] = wsf[32 + crow(r, hi)];
        } else {
#pragma unroll
            for (int r = 0; r < 16; ++r) rli[r] = 1.f;
        }
        bf16_t* Ow = it.O + (size_t)(32 * rg) * DM + hs * HD;
#pragma unroll
        for (int r = 0; r < 16; ++r) { const int orow = crow(r, hi);
#pragma unroll
            for (int d0 = 0; d0 < 4; ++d0) { const unsigned w = cvt_pk_bf16(o[d0][r] * rli[r], 0.f); Ow[(size_t)orow * DM + d0 * 32 + r32] = (bf16_t)(w & 0xffffu); } }
    }
    VM_WAIT(); __syncthreads();
#undef V_PRELOAD
#undef K_STAGE
#undef NTL
}

__device__ __forceinline__ void conv_item(int cb, int layer, const bf16_t* proj, bf16_t* Y, const float* state_conv, const float* conv_w, float* out) {
    int tid = threadIdx.x; asm volatile("" : "+v"(tid));
    const int lane = tid & 63, wid = tid >> 6;
    const int c8 = lane * 8, g0 = 64 * cb + 8 * wid;
    const bool sample = g0 >= SEQ;
    const int b = sample ? (g0 - SEQ) / DSEQ : 0;
    const int seq0 = sample ? SEQ + DSEQ * b : 0, seq_end = sample ? seq0 + DSEQ : SEQ;
    float w0[8], w1[8], w2[8], um2[8], um1[8];
    { const float* cw = conv_w + (size_t)layer * 3 * CONVD + c8;
      const f32x4 a0 = *(const f32x4*)cw, a1 = *(const f32x4*)(cw + 4), b0 = *(const f32x4*)(cw + CONVD), b1 = *(const f32x4*)(cw + CONVD + 4), c0 = *(const f32x4*)(cw + 2 * CONVD), c1 = *(const f32x4*)(cw + 2 * CONVD + 4);
#pragma unroll
      for (int i = 0; i < 4; ++i) { w0[i] = a0[i]; w0[4 + i] = a1[i]; w1[i] = b0[i]; w1[4 + i] = b1[i]; w2[i] = c0[i]; w2[4 + i] = c1[i]; } }
    auto load_u = [&](int t, float (&u)[8]) {
        const u32x4 gc = *(const u32x4*)(proj + (size_t)t * NPROJ + C_GC + c8), hc = *(const u32x4*)(proj + (size_t)t * NPROJ + C_HC + c8);
#pragma unroll
        for (int i = 0; i < 4; ++i) { u[2 * i] = bf_lo(gc[i]) * bf_lo(hc[i]); u[2 * i + 1] = bf_hi(gc[i]) * bf_hi(hc[i]); }
    };
    if (g0 == seq0) {
        if (sample) { const float* st = state_conv + ((size_t)(layer * DB + b) * 2) * CONVD + c8;
            const f32x4 a0 = *(const f32x4*)st, a1 = *(const f32x4*)(st + 4), b0 = *(const f32x4*)(st + CONVD), b1 = *(const f32x4*)(st + CONVD + 4);
#pragma unroll
            for (int i = 0; i < 4; ++i) { um2[i] = a0[i]; um2[4 + i] = a1[i]; um1[i] = b0[i]; um1[4 + i] = b1[i]; } }
        else {
#pragma unroll
            for (int i = 0; i < 8; ++i) { um2[i] = 0.f; um1[i] = 0.f; } }
    } else { load_u(g0 - 2, um2); load_u(g0 - 1, um1); }
#pragma unroll 1
    for (int t = g0; t < g0 + 8; ++t) {
        float u[8]; load_u(t, u);
        const u32x4 gb = *(const u32x4*)(proj + (size_t)t * NPROJ + C_GB + c8);
        float y[8];
#pragma unroll
        for (int i = 0; i < 4; ++i) {
            y[2 * i] = bf_lo(gb[i]) * (w0[2 * i] * um2[2 * i] + w1[2 * i] * um1[2 * i] + w2[2 * i] * u[2 * i]);
            y[2 * i + 1] = bf_hi(gb[i]) * (w0[2 * i + 1] * um2[2 * i + 1] + w1[2 * i + 1] * um1[2 * i + 1] + w2[2 * i + 1] * u[2 * i + 1]);
        }
        u32x4 w; w.x = cvt_pk_bf16(y[0], y[1]); w.y = cvt_pk_bf16(y[2], y[3]); w.z = cvt_pk_bf16(y[4], y[5]); w.w = cvt_pk_bf16(y[6], y[7]);
        *(u32x4*)(Y + (size_t)t * DM + c8) = w;
        if (t >= seq_end - 2) {
            const int which = t - (seq_end - 2);
            float* dst = sample ? out + O_SCONV + ((size_t)(layer * DB + b) * 2 + which) * CONVD + c8 : out + O_PCONV + ((size_t)layer * 2 + which) * CONVD + c8;
            *(f32x4*)dst = (f32x4){u[0], u[1], u[2], u[3]}; *(f32x4*)(dst + 4) = (f32x4){u[4], u[5], u[6], u[7]};
        }
#pragma unroll
        for (int i = 0; i < 8; ++i) { um2[i] = um1[i]; um1[i] = u[i]; }
    }
}


struct SkProj {
    bf16_t* proj; const float* ssq; float* out; int layer; unsigned* kmaxs;
    __device__ __forceinline__ void operator()(const f32x16& acc, int n0, int row, int r32, int hi) const {
        const float rs = rsqrtf(ssq[SEQ + row] * (1.0f / DM) + EPS);
        int seg = -1, segcol = 0;
        if (n0 >= C_SK && n0 < C_FQ) { seg = (n0 - C_SK) / 768; segcol = (n0 - C_SK) % 768; }
        else if (n0 >= C_FK) { seg = 2 + (n0 - C_FK) / 768; segcol = (n0 - C_FK) % 768; }
        bf16_t* pr = proj + (size_t)(SEQ + row) * NPROJ + n0 + 4 * hi;
        float* orow = out + O_SSBK + (size_t)(seg < 0 ? 0 : seg) * S_KV_STRIDE + ((size_t)layer * NSMP + row) * 768 + segcol + 4 * hi;
        float ss = 0.f;
#pragma unroll
        for (int g = 0; g < 4; ++g) {
            const f32x4 v = {acc[4 * g] * rs, acc[4 * g + 1] * rs, acc[4 * g + 2] * rs, acc[4 * g + 3] * rs};
            u32x2 w; w.x = cvt_pk_bf16(v[0], v[1]); w.y = cvt_pk_bf16(v[2], v[3]);
            *(u32x2*)(pr + 8 * g) = w;
            if (seg >= 0) *(f32x4*)(orow + 8 * g) = v;
            ss += (v[0] * v[0] + v[1] * v[1]) + (v[2] * v[2] + v[3] * v[3]);
        }
        if (n0 >= C_FK && n0 < C_FV) {
            ss = swap32_sum(ss);
            float mx = row16_max(ss);
            { auto rr = __builtin_amdgcn_permlane16_swap(__float_as_uint(mx), __float_as_uint(mx), false, false); mx = fmaxf(__uint_as_float(rr[0]), __uint_as_float(rr[1])); }
            const int head = (n0 - C_FK) / HD, part = ((n0 - C_FK) % HD) / 32, b = row >> 5;
            if (r32 == 0 && hi == 0) atomicMax(kmaxs + ((layer * DB + b) * NH + head) * 4 + part, __float_as_uint(mx));
        }
    }
};
template <bool BASE_F32> struct SkRes {
    const float* base_f; bf16_t* xb; float* ssq_out;
    __device__ __forceinline__ void operator()(const f32x16& acc, int n0, int row, int r32, int hi) const {
        bf16_t* bo = xb + (size_t)(SEQ + row) * DM + n0 + 4 * hi;
        float ss = 0.f;
#pragma unroll
        for (int g = 0; g < 4; ++g) {
            f32x4 b;
            if constexpr (BASE_F32) b = *(const f32x4*)(base_f + (size_t)row * DM + n0 + 4 * hi + 8 * g);
            else { const u32x2 w = *(const u32x2*)(bo + 8 * g); b = (f32x4){bf_lo(w.x), bf_hi(w.x), bf_lo(w.y), bf_hi(w.y)}; }
            const f32x4 v = {b[0] + acc[4 * g], b[1] + acc[4 * g + 1], b[2] + acc[4 * g + 2], b[3] + acc[4 * g + 3]};
            u32x2 w; w.x = cvt_pk_bf16(v[0], v[1]); w.y = cvt_pk_bf16(v[2], v[3]);
            *(u32x2*)(bo + 8 * g) = w;
            ss += (v[0] * v[0] + v[1] * v[1]) + (v[2] * v[2] + v[3] * v[3]);
        }
        ss = swap32_sum(ss);
        if (hi == 0) atomicAdd(ssq_out + SEQ + row, ss);
    }
};
struct SkLogit {
    const float* ssq; const float* bfl; float* out; int layer, rowbase;
    __device__ __forceinline__ void operator()(const f32x16& acc, int n0, int row, int r32, int hi) const {
        const int R = rowbase + row;
        const float rs = rsqrtf(ssq[R] * (1.0f / DM) + EPS);
        float* dst = (R < SEQ) ? out + O_PLOGF + ((size_t)layer * SEQ + R) * 6 : out + O_SLOGF + ((size_t)layer * NSMP + (R - SEQ)) * 6;
#pragma unroll
        for (int i = 0; i < 4; ++i) { const int col = 4 * hi + i;
            if (col < NH) { const float f = acc[i] * rs + bfl[col]; dst[col] = fminf(f, 0.f) - log1pf(expf(-fabsf(f))); } }
    }
};
template <int KSPLIT, class Epi> __device__ __forceinline__ void skinny_item(LAS unsigned char* lds, const bf16_t* X, int ldx, const bf16_t* Wt, int ldw, int K, int n0, int rh, const Epi& E) {
    int tid = threadIdx.x; asm volatile("" : "+v"(tid));
    const int lane = tid & 63, r32 = lane & 31, hi = lane >> 5; const int wid = __builtin_amdgcn_readfirstlane(tid >> 6);
    constexpr int RW = 8 / KSPLIT;
    const int kh = wid / RW;
    const int row0 = 32 * RW * rh + 32 * (wid % RW);
    const int Kw = K / KSPLIT, kbeg = kh * Kw;
    LAS unsigned char* Xl = lds + wid * 16384; LAS unsigned char* Wl = Xl + 8192;
    const int lrow = lane >> 4, lch = lane & 15;
    const char* xg = (const char*)(X + kbeg); const char* wg = (const char*)(Wt + (size_t)n0 * ldw + kbeg);
    const unsigned xo = (unsigned)((row0 + lrow) * ldx + lch * 8) * 2u, wo = (unsigned)(lrow * ldw + lch * 8) * 2u;
    const unsigned xstep = (unsigned)ldx * 8u, wstep = (unsigned)ldw * 8u;
    f32x16 acc = f32x16{};
    bf16x8 xs[8], ws[8];
#define SK_LOAD(k0) do { _Pragma("unroll") for (int i_ = 0; i_ < 8; ++i_) { xs[i_] = *(const bf16x8*)(xg + (xo + i_ * xstep + (unsigned)(k0) * 2u)); ws[i_] = *(const bf16x8*)(wg + (wo + i_ * wstep + (unsigned)(k0) * 2u)); } } while (0)
    const int swz = (r32 & 7) << 4;
    const int offe = lrow * 256 + ((lch * 16) ^ (lrow << 4)), offo = lrow * 256 + ((lch * 16) ^ ((lrow + 4) << 4));
    SK_LOAD(0);
    for (int k0 = 0; k0 < Kw; k0 += 128) {
#pragma unroll
        for (int i = 0; i < 8; ++i) { const int off = ((i & 1) ? offo : offe) + i * 1024; *(LAS bf16x8*)(Xl + off) = xs[i]; *(LAS bf16x8*)(Wl + off) = ws[i]; }
        if (k0 + 128 < Kw) SK_LOAD(k0 + 128);
#pragma unroll
        for (int d = 0; d < 4; ++d) { const int ka = r32 * 256 + ((d * 32 + hi * 16) ^ swz);
#pragma unroll
            for (int dh = 0; dh < 2; ++dh) {
                const bf16x8 xf = *(const LAS bf16x8*)(Xl + ka + dh * 128);
                const bf16x8 wf = *(const LAS bf16x8*)(Wl + ka + dh * 128);
                acc = __builtin_amdgcn_mfma_f32_32x32x16_bf16(wf, xf, acc, 0, 0, 0); } }
    }
#undef SK_LOAD
    if constexpr (KSPLIT > 1) {
        if (kh > 0) {
#pragma unroll
            for (int g = 0; g < 4; ++g) *(LAS f32x4*)(Xl + lane * 64 + g * 16) = (f32x4){acc[4 * g], acc[4 * g + 1], acc[4 * g + 2], acc[4 * g + 3]};
        }
        __syncthreads();
        if (kh == 0) {
#pragma unroll
            for (int p = 1; p < KSPLIT; ++p) { const LAS unsigned char* Pl = lds + (wid + p * RW) * 16384;
#pragma unroll
                for (int g = 0; g < 4; ++g) { const f32x4 q = *(const LAS f32x4*)(Pl + lane * 64 + g * 16); acc[4 * g] += q[0]; acc[4 * g + 1] += q[1]; acc[4 * g + 2] += q[2]; acc[4 * g + 3] += q[3]; } }
            E(acc, n0, row0 + r32, r32, hi);
        }
        __syncthreads();
    } else {
        E(acc, n0, row0 + r32, r32, hi);
    }
}

template <class Epi> __device__ __forceinline__ void skinny128_item(LAS unsigned char* lds, const bf16_t* X, int ldx, const bf16_t* Wt, int ldw, int K, int n0, int rh, const Epi& E) {
    int tid = threadIdx.x; asm volatile("" : "+v"(tid));
    const int lane = tid & 63, r32 = lane & 31, hi = lane >> 5; const int wid = __builtin_amdgcn_readfirstlane(tid >> 6);
    const int wrow = wid >> 1, wcol = wid & 1;
    const int lrow = lane >> 4, lch = lane & 15;
    const char* xg = (const char*)(X + (size_t)(128 * rh + 16 * wid) * ldx); const char* wg = (const char*)(Wt + (size_t)(n0 + 16 * wid) * ldw);
    const unsigned xoe = (unsigned)(lrow * ldx + (lch ^ lrow) * 8) * 2u, xoo = (unsigned)((lrow + 4) * ldx + (lch ^ (lrow + 4)) * 8) * 2u;
    const unsigned woe = (unsigned)(lrow * ldw + (lch ^ lrow) * 8) * 2u, woo = (unsigned)((lrow + 4) * ldw + (lch ^ (lrow + 4)) * 8) * 2u;
    const size_t x8 = (size_t)ldx * 16, w8 = (size_t)ldw * 16;
#define SK128_STAGE(t, b) do { LAS unsigned char* xl_ = lds + (b) * 65536 + wid * 4096; LAS unsigned char* wl_ = xl_ + 32768; const char* xs_ = xg + (size_t)(t) * 256; const char* ws_ = wg + (size_t)(t) * 256; \
        __builtin_amdgcn_global_load_lds((const unsigned*)(xs_ + xoe), (LAS unsigned*)(xl_), 16, 0, 0);             __builtin_amdgcn_global_load_lds((const unsigned*)(xs_ + xoo), (LAS unsigned*)(xl_ + 1024), 16, 0, 0); \
        __builtin_amdgcn_global_load_lds((const unsigned*)(xs_ + x8 + xoe), (LAS unsigned*)(xl_ + 2048), 16, 0, 0); __builtin_amdgcn_global_load_lds((const unsigned*)(xs_ + x8 + xoo), (LAS unsigned*)(xl_ + 3072), 16, 0, 0); \
        __builtin_amdgcn_global_load_lds((const unsigned*)(ws_ + woe), (LAS unsigned*)(wl_), 16, 0, 0);             __builtin_amdgcn_global_load_lds((const unsigned*)(ws_ + woo), (LAS unsigned*)(wl_ + 1024), 16, 0, 0); \
        __builtin_amdgcn_global_load_lds((const unsigned*)(ws_ + w8 + woe), (LAS unsigned*)(wl_ + 2048), 16, 0, 0); __builtin_amdgcn_global_load_lds((const unsigned*)(ws_ + w8 + woo), (LAS unsigned*)(wl_ + 3072), 16, 0, 0); } while (0)
    f32x16 acc0 = f32x16{}, acc1 = f32x16{};
    const int nst = K / 128;
    const int swz = (r32 & 7) << 4;
    SK128_STAGE(0, 0);
    for (int t = 0; t < nst; ++t) {
        VM_WAIT(); __syncthreads();
        if (t + 1 < nst) SK128_STAGE(t + 1, (t + 1) & 1);
        const LAS unsigned char* Xl = lds + (t & 1) * 65536 + wrow * 8192; const LAS unsigned char* Wl = lds + (t & 1) * 65536 + 32768 + wcol * 16384;
#pragma unroll
        for (int d = 0; d < 4; ++d) { const int ka = r32 * 256 + ((d * 32 + hi * 16) ^ swz);
#pragma unroll
            for (int dh = 0; dh < 2; ++dh) {
                const bf16x8 xf = *(const LAS bf16x8*)(Xl + ka + dh * 128);
                const bf16x8 w0 = *(const LAS bf16x8*)(Wl + ka + dh * 128), w1 = *(const LAS bf16x8*)(Wl + 8192 + ka + dh * 128);
                acc0 = __builtin_amdgcn_mfma_f32_32x32x16_bf16(w0, xf, acc0, 0, 0, 0);
                acc1 = __builtin_amdgcn_mfma_f32_32x32x16_bf16(w1, xf, acc1, 0, 0, 0); } }
    }
#undef SK128_STAGE
    E(acc0, n0 + 64 * wcol, 128 * rh + 32 * wrow + r32, r32, hi);
    E(acc1, n0 + 64 * wcol + 32, 128 * rh + 32 * wrow + r32, r32, hi);
    __syncthreads();
}

struct TrItem { const float* src; int ldw; const float* g; bf16_t* dst; int K; };
__device__ __forceinline__ void tr_load(const TrItem& t, f32x2 (&v)[16], int lane) {
    const int kq = lane >> 4, nn = (lane & 15) * 2;
#pragma unroll
    for (int i = 0; i < 16; ++i) v[i] = __builtin_nontemporal_load((const f32x2*)(t.src + (size_t)(4 * i + kq) * t.ldw + nn));
}
__device__ __forceinline__ void tr_process(const TrItem& t, const f32x2 (&v)[16], LAS float* scr, int lane) {
    const int kq = lane >> 4, nn = (lane & 15) * 2;
#pragma unroll
    for (int i = 0; i < 16; ++i) { scr[(4 * i + kq) * 33 + nn] = v[i].x; scr[(4 * i + kq) * 33 + nn + 1] = v[i].y; }
    LDS_WAIT(); asm volatile("" ::: "memory");
    const int c = lane & 7;
    float gv[8];
    if (t.g) { const f32x4 a = *(const f32x4*)(t.g + 8 * c), b = *(const f32x4*)(t.g + 8 * c + 4);
#pragma unroll
        for (int i = 0; i < 4; ++i) { gv[i] = a[i]; gv[4 + i] = b[i]; } }
    else {
#pragma unroll
        for (int i = 0; i < 8; ++i) gv[i] = 1.f; }
#pragma unroll
    for (int j = 0; j < 4; ++j) { const int n = (lane >> 3) + 8 * j; const LAS float* s = scr + (8 * c) * 33 + n;
        u32x4 o; o.x = cvt_pk_bf16(s[0 * 33] * gv[0], s[1 * 33] * gv[1]); o.y = cvt_pk_bf16(s[2 * 33] * gv[2], s[3 * 33] * gv[3]);
        o.z = cvt_pk_bf16(s[4 * 33] * gv[4], s[5 * 33] * gv[5]); o.w = cvt_pk_bf16(s[6 * 33] * gv[6], s[7 * 33] * gv[7]);
        *(u32x4*)(t.dst + (size_t)n * t.K + 8 * c) = o; }
    LDS_WAIT(); asm volatile("" ::: "memory");
}

struct TrCtx { const float *win, *wout, *wgate, *wup, *wdown, *n1g, *n2g; bf16_t *WIN, *WOUT, *WGU, *WDN; };
constexpr int TR_PD1 = 5376;
constexpr int TR_W1PB = 768;
constexpr int TR_IN = 32 * 192, TR_OUT = 32 * 64, TR_G = 32 * 176, TR_D = 88 * 64, TR_L = TR_IN + TR_OUT + 2 * TR_G + TR_D, TR_ALL = 2 * TR_L;
__device__ __forceinline__ void tr_kn(int r, int nblk, int& kb, int& nb) {
    const int B = r >> 3, w = r & 7, nq = nblk >> 2;
    kb = 2 * (B / nq) + (w >> 2); nb = 4 * (B % nq) + (w & 3);
}
__device__ __forceinline__ TrItem tr_decode(const TrCtx& c, int it) {
    const int l = it / TR_L; int r = it % TR_L; TrItem t; int kb, nb;
    if (r < TR_IN) { tr_kn(r, 192, kb, nb); t.src = c.win + ((size_t)l * DM + 64 * kb) * IN_DIM + 32 * nb; t.ldw = IN_DIM; t.g = c.n1g + l * DM + 64 * kb; t.dst = c.WIN + l * WIN_L + (size_t)(32 * nb) * DM + 64 * kb; t.K = DM; return t; }
    r -= TR_IN;
    if (r < TR_OUT) { tr_kn(r, 64, kb, nb); t.src = c.wout + ((size_t)l * DM + 64 * kb) * DM + 32 * nb; t.ldw = DM; t.g = nullptr; t.dst = c.WOUT + l * WOUT_L + (size_t)(32 * nb) * DM + 64 * kb; t.K = DM; return t; }
    r -= TR_OUT;
    if (r < 2 * TR_G) { const int up = r / TR_G; r %= TR_G; tr_kn(r, 176, kb, nb); const int n0 = 32 * nb;
        t.src = (up ? c.wup : c.wgate) + ((size_t)l * DM + 64 * kb) * DFF + n0; t.ldw = DFF; t.g = c.n2g + l * DM + 64 * kb;
        t.dst = c.WGU + l * WGU_L + (size_t)(256 * (n0 / 128) + 128 * up + (n0 % 128)) * DM + 64 * kb; t.K = DM; return t; }
    r -= 2 * TR_G;
    { tr_kn(r, 64, kb, nb); t.src = c.wdown + ((size_t)l * DFF + 64 * kb) * DM + 32 * nb; t.ldw = DM; t.g = nullptr; t.dst = c.WDN + l * WDN_L + (size_t)(32 * nb) * DFF + 64 * kb; t.K = DFF; return t; }
}
template <int N> __device__ __forceinline__ void tr_run(const TrCtx& c, int u0, LAS float* scr, int lane) {
    f32x2 va[16], vb[16];
    TrItem ta = tr_decode(c, u0), tb;
    tr_load(ta, va, lane);
#pragma unroll 1
    for (int uu = 0; uu < N; uu += 2) {
        tb = tr_decode(c, u0 + uu + 1); tr_load(tb, vb, lane);
        tr_process(ta, va, scr, lane);
        if (uu + 2 < N) { ta = tr_decode(c, u0 + uu + 2); tr_load(ta, va, lane); }
        tr_process(tb, vb, scr, lane);
    }
}
template <int NIT> __device__ __forceinline__ void knorm_items(const float* cfk, int it0, float* kpart, int lane) {
    const int half = lane >> 5, c4 = (lane & 31) * 4;
    f32x4 va[12], vb[12];
    float hm[6];
#define KN_LOAD(V, q) do { const int it_ = it0 + ((q) >> 2), pq_ = (q) & 3; const float* b_ = cfk + ((size_t)(it_ / (PAST / 16)) * PAST + (it_ % (PAST / 16)) * 16) * 768; \
        _Pragma("unroll") for (int u_ = 0; u_ < 2; ++u_) _Pragma("unroll") for (int h_ = 0; h_ < 6; ++h_) V[u_ * 6 + h_] = __builtin_nontemporal_load((const f32x4*)(b_ + (size_t)((2 * (2 * pq_ + u_) + half) * 6 + h_) * 128 + c4)); } while (0)
#define KN_REDUCE(V, q) do { if (((q) & 3) == 0) { _Pragma("unroll") for (int h_ = 0; h_ < 6; ++h_) hm[h_] = 0.f; } \
        _Pragma("unroll") for (int u_ = 0; u_ < 2; ++u_) _Pragma("unroll") for (int h_ = 0; h_ < 6; ++h_) { const f32x4 w_ = V[u_ * 6 + h_]; float ss_ = (w_[0] * w_[0] + w_[1] * w_[1]) + (w_[2] * w_[2] + w_[3] * w_[3]); \
            ss_ = swap16_sum(row16_sum(ss_)); hm[h_] = fmaxf(hm[h_], ss_); } \
        if (((q) & 3) == 3) { const int it_ = it0 + ((q) >> 2), lb_ = it_ / (PAST / 16); \
            _Pragma("unroll") for (int h_ = 0; h_ < 6; ++h_) { const float mx_ = swap32_max(hm[h_]); if (lane == 0) kpart[(size_t)(lb_ * NH + h_) * (PAST / 16) + (it_ % (PAST / 16))] = mx_; } } } while (0)
    KN_LOAD(va, 0);
#pragma unroll 1
    for (int q = 0; q < 4 * NIT; q += 2) {
        KN_LOAD(vb, q + 1);
        KN_REDUCE(va, q);
        if (q + 2 < 4 * NIT) KN_LOAD(va, q + 2);
        KN_REDUCE(vb, q + 1);
    }
#undef KN_LOAD
#undef KN_REDUCE
}

#ifndef PB_MASK
#define PB_MASK 31
#endif
#ifndef TIMING
#define TIMING 0
#define TIMING_BX 0
#endif
#define STAMP2(i) do { int t_ = threadIdx.x; asm volatile("" : "+v"(t_)); if (TIMING == 2 && bx == TIMING_BX && t_ == 0) MISC[16 + (i)] = (unsigned)__builtin_amdgcn_s_memrealtime(); } while (0)
#define STAMP3(i) do { int t_ = threadIdx.x; asm volatile("" : "+v"(t_)); if (TIMING == 3 && bx == TIMING_BX && t_ == 0) MISC[16 + (i)] = (unsigned)__builtin_amdgcn_s_memrealtime(); } while (0)
#define STAMP(i) do { int t_ = threadIdx.x; asm volatile("" : "+v"(t_)); if ((TIMING == 1 || TIMING == 3) && bx == TIMING_BX && t_ == 0) MISC[16 + (i)] = (unsigned)__builtin_amdgcn_s_memrealtime(); } while (0)
#ifndef STOP_AFTER
#define STOP_AFTER 99
#endif
struct Params { const float* in[18]; float* out; unsigned char* ws; };
enum { I_XP = 0, I_XS, I_SCONV, I_CSBK, I_CSBV, I_CFK, I_CFV, I_CLOGF, I_N1G, I_WIN, I_BF, I_CONVW, I_WOUT, I_N2G, I_WGATE, I_WUP, I_WDOWN, I_FG };

#define KARG(i) (*(const float* const volatile __attribute__((address_space(4)))*)((const __attribute__((address_space(4))) char*)__builtin_amdgcn_kernarg_segment_ptr() + 8 * (i)))
__global__ void __launch_bounds__(512, 2) hybrid_fwd(Params P) {
    extern __shared__ __attribute__((aligned(16))) unsigned char lds_raw[];
    LAS unsigned char* lds = (LAS unsigned char*)lds_raw;
    volatile LAS unsigned* MISC = (volatile LAS unsigned*)(lds + MISC_OFF);
    const int tid = threadIdx.x, lane = tid & 63; const int wave = __builtin_amdgcn_readfirstlane(tid >> 6);
    const int G = gridDim.x; const int bx = blockIdx.x; const int vcu = (G % 8 == 0) ? (bx % 8) * (G / 8) + bx / 8 : bx;
    const int gw = vcu * 8 + wave, NGW = G * 8;
    unsigned char* ws = P.ws;
    unsigned* ctl = (unsigned*)(ws + WS_CTL);
    float* out = P.out;
    bf16_t* WFB = (bf16_t*)(ws + WS_WF); float* KPART = (float*)(ws + WS_WF + 524288);
    bf16_t* WIN = (bf16_t*)(ws + WS_WIN); bf16_t* WOUT = (bf16_t*)(ws + WS_WOUT); bf16_t* WGU = (bf16_t*)(ws + WS_WGU); bf16_t* WDN = (bf16_t*)(ws + WS_WDN);
    bf16_t* XB = (bf16_t*)(ws + WS_XB); bf16_t* PROJ = (bf16_t*)(ws + WS_PROJ); bf16_t* Y = (bf16_t*)(ws + WS_Y); bf16_t* H = (bf16_t*)(ws + WS_H);
    float* SSQ = (float*)(ctl + CW_SSQ);
    for (int u = tid; u < (LDS_BYTES - RING_BYTES) / 4; u += 512) ((LAS unsigned*)(lds + RING_BYTES))[u] = 0u;
    __syncthreads();
    XcdBarrier bar = xcd_barrier_post(ctl + CW_BAR, MISC + 8);
    STAMP(0); STAMP2(0);

    {
        LAS float* scr = (LAS float*)(lds + wave * 16384);
        constexpr int NITEMS = TR_IN;
        const TrCtx TC{P.in[I_WIN], P.in[I_WOUT], P.in[I_WGATE], P.in[I_WUP], P.in[I_WDOWN], P.in[I_N1G], P.in[I_N2G], WIN, WOUT, WGU, WDN};
        constexpr int N_ROWS = MT, N_KN = DB * (PAST / 16), Q_KN = N_KN / 8, Q_TR = NITEMS / 32, Q_ROW = N_ROWS / 32, Q_ALL = Q_KN + Q_TR + Q_ROW;
        volatile LAS unsigned* qidx0 = MISC + 12;
        for (;;) {
            if (tid == 0) qidx0[0] = __hip_atomic_fetch_add(ctl + CW_Q + 128, 1u, __ATOMIC_RELAXED, __HIP_MEMORY_SCOPE_AGENT);
            __syncthreads();
            const int qi = (int)qidx0[0];
            __syncthreads();
            if (qi >= Q_ALL) break;
            if (qi < Q_KN) { knorm_items<1>(P.in[I_CFK], qi * 8 + wave, KPART, lane); continue; }
            if (qi < Q_KN + Q_TR) { tr_run<4>(TC, ((qi - Q_KN) * 8 + wave) * 4, scr, lane); continue; }
            {
                const int r0 = ((qi - Q_KN - Q_TR) * 8 + wave) * 4;
                f32x4 xa[8], xb[8];
#define ROW_PTR(r) (((r) < SEQ) ? P.in[I_XP] + (size_t)(r) * DM : P.in[I_XS] + (size_t)((r) - SEQ) * DM)
#define ROW_LOAD(V, r) do { const float* xr_ = ROW_PTR(r); _Pragma("unroll") for (int i_ = 0; i_ < 4; ++i_) { V[2 * i_] = __builtin_nontemporal_load((const f32x4*)(xr_ + 8 * lane + 512 * i_)); V[2 * i_ + 1] = __builtin_nontemporal_load((const f32x4*)(xr_ + 8 * lane + 512 * i_ + 4)); } } while (0)
#define ROW_DONE(V, r) do { float s_ = 0.f; _Pragma("unroll") for (int i_ = 0; i_ < 4; ++i_) { const f32x4 a_ = V[2 * i_], b_ = V[2 * i_ + 1]; \
        s_ += (a_[0] * a_[0] + a_[1] * a_[1]) + (a_[2] * a_[2] + a_[3] * a_[3]) + (b_[0] * b_[0] + b_[1] * b_[1]) + (b_[2] * b_[2] + b_[3] * b_[3]); \
        u32x4 w_; w_.x = cvt_pk_bf16(a_[0], a_[1]); w_.y = cvt_pk_bf16(a_[2], a_[3]); w_.z = cvt_pk_bf16(b_[0], b_[1]); w_.w = cvt_pk_bf16(b_[2], b_[3]); \
        *(u32x4*)(XB + (size_t)(r) * DM + 8 * lane + 512 * i_) = w_; } \
        s_ = wave_sum(s_); if (lane == 0) SSQ[(r)] = s_; } while (0)
                ROW_LOAD(xa, r0);
#pragma unroll 1
                for (int uu = 0; uu < 4; uu += 2) {
                    ROW_LOAD(xb, r0 + uu + 1);
                    ROW_DONE(xa, r0 + uu);
                    if (uu + 2 < 4) ROW_LOAD(xa, r0 + uu + 2);
                    ROW_DONE(xb, r0 + uu + 1);
                }
#undef ROW_PTR
#undef ROW_LOAD
#undef ROW_DONE
            }
        }
        STAMP2(2);
        for (int e = vcu * 512 + tid; e < 2 * 32 * DM; e += G * 512) {
            const int l = e / (32 * DM), j = (e % (32 * DM)) / DM, k = e % DM;
            const float v = (j < NH) ? P.in[I_N1G][l * DM + k] * P.in[I_WIN][((size_t)l * DM + k) * IN_DIM + NPROJ + j] : 0.f;
            WFB[e] = (bf16_t)(cvt_pk_bf16(v, 0.f) & 0xffffu);
        }
        STAMP2(3);
    }
    STAMP2(4);
    xcd_barrier(bar);
    STAMP(1); STAMP2(5);

    for (int l = 0; l < 2; ++l) {
        int tid = threadIdx.x; asm volatile("" : "+v"(tid)); const int lane = tid & 63; const int gw = vcu * 8 + __builtin_amdgcn_readfirstlane(tid >> 6);
        long zoff = 0; asm volatile("" : "+s"(zoff));
        unsigned char* ws = P.ws + zoff; float* out = P.out + zoff;
        unsigned* ctl = (unsigned*)(ws + WS_CTL);
        bf16_t* WFB = (bf16_t*)(ws + WS_WF); float* KPART = (float*)(ws + WS_WF + 524288);
        bf16_t* WIN = (bf16_t*)(ws + WS_WIN); bf16_t* WOUT = (bf16_t*)(ws + WS_WOUT); bf16_t* WGU = (bf16_t*)(ws + WS_WGU); bf16_t* WDN = (bf16_t*)(ws + WS_WDN);
        bf16_t* XB = (bf16_t*)(ws + WS_XB); bf16_t* PROJ = (bf16_t*)(ws + WS_PROJ); bf16_t* Y = (bf16_t*)(ws + WS_Y); bf16_t* H = (bf16_t*)(ws + WS_H);
        float* SSQ = (float*)(ctl + CW_SSQ);
        const float* ssq_in = SSQ + (size_t)(2 * l) * MT;
        float* ssq_mid = SSQ + (size_t)(2 * l + 1) * MT;
        float* ssq_next = SSQ + (size_t)(2 * l + 2) * MT;
        {
            if (l == 0) STAMP2(6);
            const SkProj SE{PROJ, ssq_in, out, l, ctl + CW_KMAXS};
            constexpr int NSK = 2 * (NPROJ / 128), NLG = 4 * (MT / 256);
            int si0, si1, sis, lq0, lq1, lqs;
            if (G == 256) { const int x = (bx & 7) >> 1, i = bx >> 3, hr = (bx >> 3) * 4 + ((bx & 7) >> 1);
                const bool lightw = !(bx & 1);
                si0 = (lightw && i < 24) ? x * 24 + i : NSK; si1 = NSK; sis = 1 << 20;
                lq0 = lightw ? (i >= 24 ? 128 + x * 8 + (i - 24) : NLG) : hr; lq1 = NLG; lqs = 1 << 20;
            } else { si0 = bx; si1 = NSK; sis = G; lq0 = bx; lq1 = NLG; lqs = G; }
            for (int i = si0; i < si1; i += sis) skinny128_item(lds, XB + (size_t)SEQ * DM, DM, WIN + l * WIN_L, DM, DM, 128 * (i >> 1), i & 1, SE);
            const bool lg_first = (G == 256) && ((bx >> 3) & 1);
            if (lg_first) for (int q = lq0; q < lq1; q += lqs) {
                const SkLogit LE{ssq_in, KARG(I_BF) + l * NH, out, l, 256 * (q >> 2)};
                skinny_item<4>(lds, XB + (size_t)(q >> 2) * 256 * DM, DM, WFB + (size_t)l * 32 * DM, DM, DM, 0, q & 3, LE);
            }
            if (l == 0) STAMP2(7);
            pg8::Gemm g{XB, WIN + l * WIN_L, SEQ, NPROJ, DM}; pg8::StaticOrder S; S.init(SEQ, NPROJ, G, bx, 1);
            pg8::EpiProj E{PROJ, ssq_in, out, l, ctl + CW_KMAXP};
            pg8::gemm_phase<pg8::EpiProj, pg8::StaticOrder, true, true>(lds, g, S, E);
            if (l == 0) STAMP(2);
            if (!lg_first) for (int q = lq0; q < lq1; q += lqs) {
                const SkLogit LE{ssq_in, KARG(I_BF) + l * NH, out, l, 256 * (q >> 2)};
                skinny_item<4>(lds, XB + (size_t)(q >> 2) * 256 * DM, DM, WFB + (size_t)l * 32 * DM, DM, DM, 0, q & 3, LE);
            }
        }
        if (l == 0) STAMP2(8);
        xcd_barrier(bar);
        STAMP(l == 0 ? 3 : 10); if (l == 0) STAMP2(9);
        if (STOP_AFTER == 1 + 5 * l) return;
        {
            constexpr int NHP = NH / 2, N_PA = 2 * 64 * NHP, N_SA = 2 * DB * NHP, N_CV = MT / 64, N_ALL = N_PA + N_SA + N_CV;
            const int n_a = N_ALL + (l == 0 ? DB * (PAST / 16) / 8 : 0);
            const bool win1_in_pd = (G == 256);
            const int cv_first = (l == 0) ? TR_IN : TR_L + TR_IN, n_b = ((l == 0) ? (win1_in_pd ? TR_L - TR_IN + TR_W1PB : TR_L) : TR_L - TR_IN - (win1_in_pd ? TR_PD1 : 0)) / 32;
            const int n_min = n_a < n_b ? n_a : n_b, n_items = n_a + n_b;
            const TrCtx TC{KARG(I_WIN), KARG(I_WOUT), KARG(I_WGATE), KARG(I_WUP), KARG(I_WDOWN), KARG(I_N1G), KARG(I_N2G), WIN, WOUT, WGU, WDN};
            volatile LAS unsigned* qidx = MISC + 12;
            for (;;) {
                if (tid == 0) qidx[0] = __hip_atomic_fetch_add(ctl + CW_Q + 64 * l, 1u, __ATOMIC_RELAXED, __HIP_MEMORY_SCOPE_AGENT);
                __syncthreads();
                const int qi = (int)qidx[0];
                __syncthreads();
                if (qi >= n_items) break;
                int idx, cvi = -1;
                if (qi < 2 * n_min) { if (qi & 1) cvi = qi >> 1; idx = qi >> 1; } else if (n_a > n_b) idx = qi - n_min; else { cvi = qi - n_min; idx = 0; }
                if (cvi >= 0) { tr_run<4>(TC, cv_first + (cvi * 8 + __builtin_amdgcn_readfirstlane(tid >> 6)) * 4, (LAS float*)(lds + __builtin_amdgcn_readfirstlane(tid >> 6) * 16384), lane); continue; }
                {
                    const int n_kn = n_a - N_ALL, ia = idx - (N_PA + N_SA);
                    if (ia >= 0 && ia < n_kn) { knorm_items<1>(KARG(I_CFK), DB * (PAST / 16) + ia * 8 + __builtin_amdgcn_readfirstlane(tid >> 6), KPART, lane); continue; }
                    if (ia >= n_kn) idx -= n_kn;
                }
                if (idx < N_PA + N_SA) {
                    AttnItem it;
                    int type, h, b = 0;
                    if (idx >= N_SA) { const int ip = idx - N_SA; type = ip / (64 * NHP); const int rem = ip % (64 * NHP); const int qt = 63 - rem / NHP; h = 2 * (rem % NHP);
                        it.nq = 128; it.t0 = 128 * qt; it.Kc = 0; it.Knew_cnt = SEQ;
                        it.Q = PROJ + (size_t)it.t0 * NPROJ; it.Knew = PROJ; it.Vnew = PROJ; it.Kcache = nullptr; it.Vcache = nullptr; it.Lcache = nullptr;
                        it.Lnew = out + O_PLOGF + (size_t)l * SEQ * 6 + h; it.O = Y + (size_t)it.t0 * DM;
                        const unsigned* km = ctl + CW_KMAXP + (l * NH + h) * 4;
                        it.kn2 = (__uint_as_float(km[0]) + __uint_as_float(km[1])) + (__uint_as_float(km[2]) + __uint_as_float(km[3]));
                        it.kn2b = (__uint_as_float(km[4]) + __uint_as_float(km[5])) + (__uint_as_float(km[6]) + __uint_as_float(km[7]));
                    } else { const int k = idx; type = k / (DB * NHP); b = (k % (DB * NHP)) / NHP; h = 2 * (k % NHP);
                        it.nq = DSEQ; it.t0 = PAST; it.Kc = PAST; it.Knew_cnt = DSEQ;
                        const size_t row0 = (size_t)SEQ + DSEQ * b;
                        it.Q = PROJ + row0 * NPROJ; it.Knew = PROJ + row0 * NPROJ; it.Vnew = PROJ + row0 * NPROJ;
                        const size_t coff = ((size_t)(l * DB + b) * PAST) * 768 + h * HD;
                        it.Kcache = P.in[type == 0 ? I_CSBK : I_CFK] + coff; it.Vcache = P.in[type == 0 ? I_CSBV : I_CFV] + coff;
                        it.Lcache = KARG(I_CLOGF) + ((size_t)(l * DB + b) * PAST) * 6 + h;
                        it.Lnew = out + O_SLOGF + ((size_t)l * NSMP + DSEQ * b) * 6 + h; it.O = Y + row0 * DM;
                        const unsigned* km = ctl + CW_KMAXS + ((l * DB + b) * NH + h) * 4;
                        const float kn_new = (__uint_as_float(km[0]) + __uint_as_float(km[1])) + (__uint_as_float(km[2]) + __uint_as_float(km[3]));
                        const float kn_newb = (__uint_as_float(km[4]) + __uint_as_float(km[5])) + (__uint_as_float(km[6]) + __uint_as_float(km[7]));
                        float kc = KPART[(size_t)((l * DB + b) * NH + h + (tid >> 8)) * (PAST / 16) + (tid & 255)];
                        kc = swap32_max(fmaxf(row16_max(kc), 0.f)); { auto rr = __builtin_amdgcn_permlane16_swap(__float_as_uint(kc), __float_as_uint(kc), false, false); kc = fmaxf(__uint_as_float(rr[0]), __uint_as_float(rr[1])); }
                        volatile LAS float* kred = (volatile LAS float*)(lds + AL_FLAG + 128);
                        if (lane == 0) kred[tid >> 6] = kc;
                        __syncthreads();
                        it.kn2 = fmaxf(kn_new, fmaxf(fmaxf(kred[0], kred[1]), fmaxf(kred[2], kred[3])));
                        it.kn2b = fmaxf(kn_newb, fmaxf(fmaxf(kred[4], kred[5]), fmaxf(kred[6], kred[7])));
                    }
                    it.sb = (type == 0);
                    const int cq_ = (type == 0 ? C_SQ : C_FQ) + h * HD, ck_ = (type == 0 ? C_SK : C_FK) + h * HD, cv_ = (type == 0 ? C_SV : C_FV) + h * HD;
                    it.Q += cq_; it.Knew += ck_; it.Vnew += cv_; it.O += (type == 0 ? CONVD : CONVD + NH * HD) + h * HD;
                    const int pbit = (idx >= N_SA ? 1 : 4) << (type == 0 ? 0 : 1);
                    if (PB_MASK & pbit) { if (type == 0) attn_item<1>(it, lds); else attn_item<0>(it, lds); }
                } else {
                    if (PB_MASK & 16) conv_item(idx - (N_PA + N_SA), l, PROJ, Y, KARG(I_SCONV), KARG(I_CONVW), out);
                }
            }
        }
        xcd_barrier(bar);
        STAMP(l == 0 ? 4 : 11); if (l == 0) STAMP2(10);
        if (STOP_AFTER == 2 + 5 * l) {
            for (size_t e = (size_t)bx * 512 + tid; e < (size_t)SEQ * DM; e += (size_t)G * 512) out[O_YP + e] = bf_lo((unsigned)Y[e]);
            return; }
        {
            pg8::Gemm g{Y, WOUT + l * WOUT_L, SEQ, DM, DM}; pg8::StaticOrder S; S.init(SEQ, DM, G, bx);
            const int nsk = 4 * (DM / 32);
            const bool sk_first = (G == 256) && ((bx >> 3) & 1);
            {
                pg8::EpiRes<false> E{nullptr, XB, ssq_mid};
                const SkRes<false> SE{nullptr, XB, ssq_mid};
#pragma unroll 1
                for (int step = 0; step < 2; ++step) {
                    if ((step == 0) == sk_first) { for (int i = bx; i < nsk; i += G) skinny_item<4>(lds, Y + (size_t)SEQ * DM, DM, WOUT + l * WOUT_L, DM, DM, 32 * (i >> 2), i & 3, SE); }
                    else { pg8::gemm_phase<pg8::EpiRes<false>, pg8::StaticOrder, true, true>(lds, g, S, E); if (l == 0) { STAMP(5); STAMP2(11); } }
                }
            }
        }
        if (l == 0) STAMP2(12);
        xcd_barrier(bar);
        STAMP(l == 0 ? 6 : 12); if (l == 0) STAMP2(13);
        if (STOP_AFTER == 3 + 5 * l) {
            for (size_t e = (size_t)bx * 512 + tid; e < (size_t)SEQ * DM; e += (size_t)G * 512) out[O_YP + e] = bf_lo((unsigned)XB[e]);
            return; }
        {
            pg8::Gemm g{XB, WGU + l * WGU_L, MT, NGU, DM}; pg8::StaticOrder S; S.init(MT, NGU, G, bx);
            pg8::EpiGU E{H, ssq_mid};
            pg8::gemm_phase<pg8::EpiGU, pg8::StaticOrder, true, true>(lds, g, S, E);
            constexpr int N_PD = (MT / 256) * (NGU / 256), N_LAST = N_PD % 256;
            if (l == 1 && G == 256 && bx >= N_LAST) {
                const TrCtx TC{KARG(I_WIN), KARG(I_WOUT), KARG(I_WGATE), KARG(I_WUP), KARG(I_WDOWN), KARG(I_N1G), KARG(I_N2G), WIN, WOUT, WGU, WDN};
                int tc = threadIdx.x; asm volatile("" : "+v"(tc));
                const int lane = tc & 63; const int wv = __builtin_amdgcn_readfirstlane(tc >> 6);
                for (int u = 2 * TR_L - TR_PD1 + ((bx - N_LAST) * 8 + wv) * 4; u < 2 * TR_L; u += (256 - N_LAST) * 8 * 4) tr_run<4>(TC, u, (LAS float*)(lds + wv * 16384), lane);
            }
            if (l == 0 && G == 256 && bx >= N_LAST) {
                const TrCtx TC{KARG(I_WIN), KARG(I_WOUT), KARG(I_WGATE), KARG(I_WUP), KARG(I_WDOWN), KARG(I_N1G), KARG(I_N2G), WIN, WOUT, WGU, WDN};
                const int wv = __builtin_amdgcn_readfirstlane(tid >> 6);
                for (int u = TR_L + TR_W1PB + ((bx - N_LAST) * 8 + wv) * 4; u < TR_L + TR_IN; u += (256 - N_LAST) * 8 * 4) tr_run<4>(TC, u, (LAS float*)(lds + wv * 16384), lane);
            }
        }
        xcd_barrier(bar);
        if (TIMING == 3) { if (l == 0) STAMP3(7); } else STAMP(l == 0 ? 7 : 13); if (l == 0) STAMP2(14);
        if (STOP_AFTER == 4 + 5 * l) {
            for (size_t e = (size_t)bx * 512 + tid; e < (size_t)SEQ * DM; e += (size_t)G * 512) out[O_YP + e] = bf_lo((unsigned)H[(e / DM) * DFF + (e % DM)]);
            return; }
        {
            pg8::Gemm g{H, WDN + l * WDN_L, SEQ, DM, DFF}; pg8::StaticOrder S; S.init(SEQ, DM, G, bx);
            pg8::EpiRes<false> E{nullptr, XB, ssq_next};
            const SkRes<false> SE{nullptr, XB, ssq_next};
            const bool sk_first = (G == 256) && ((bx >> 3) & 1);
#pragma unroll 1
            for (int step = 0; step < 2; ++step) {
                if ((step == 0) == sk_first) { for (int i = bx; i < 4 * (DM / 32); i += G) skinny_item<4>(lds, H + (size_t)SEQ * DFF, DFF, WDN + l * WDN_L, DFF, DFF, 32 * (i >> 2), i & 3, SE); }
                else { pg8::gemm_phase<pg8::EpiRes<false>, pg8::StaticOrder, true, true>(lds, g, S, E); if (l == 0) STAMP(8); }
            }
        }
        xcd_barrier(bar);
        if (TIMING == 3) STAMP3(l == 0 ? 9 : 13); else STAMP(l == 0 ? 9 : 14);
        if (STOP_AFTER == 5 + 5 * l) {
            for (size_t e = (size_t)bx * 512 + tid; e < (size_t)SEQ * DM; e += (size_t)G * 512) out[O_YP + e] = bf_lo((unsigned)XB[e]);
            return; }
    }
    {
        int tid_f = threadIdx.x; asm volatile("" : "+v"(tid_f));
        const int lane = tid_f & 63; const int gw = vcu * 8 + __builtin_amdgcn_readfirstlane(tid_f >> 6);
        const float* ssq_f = SSQ + (size_t)4 * MT; const float* fg = KARG(I_FG);
        const unsigned tmo = __hip_atomic_load(ctl + CW_BAR + XB_TMO, __ATOMIC_RELAXED, __HIP_MEMORY_SCOPE_AGENT);
        const int n_main = SEQ / NGW + ((gw < SEQ % NGW) ? 1 : 0), n_all = n_main + ((__builtin_amdgcn_readfirstlane(tid_f >> 6) == 0) ? (NSMP - vcu + G - 1) / G : 0);
        for (int q = 0; q < n_all; ++q) {
            const int r = (q < n_main) ? gw + q * NGW : SEQ + vcu + (q - n_main) * G;
            float rs = rsqrtf(ssq_f[r] * (1.0f / DM) + EPS);
            if (tmo) rs = __builtin_nanf("");
            const bf16_t* xr = XB + (size_t)r * DM; float* yo = (r < SEQ) ? out + O_YP + (size_t)r * DM : out + O_YS + (size_t)(r - SEQ) * DM;
#pragma unroll
            for (int i = 0; i < 8; ++i) { const u32x2 w = *(const u32x2*)(xr + 4 * lane + 256 * i); const f32x4 x = {bf_lo(w.x), bf_hi(w.x), bf_lo(w.y), bf_hi(w.y)}, gq = *(const f32x4*)(fg + 4 * lane + 256 * i);
                __builtin_nontemporal_store(x * rs * gq, (f32x4*)(yo + 4 * lane + 256 * i)); }
        }
    }
    if (TIMING) {
        STAMP(15); STAMP3(14);
        xcd_barrier(bar);
        if (bx == TIMING_BX) {
            const size_t offs[15] = {O_YP, O_YS, O_PCONV, O_PSBK, O_PSBV, O_PFK, O_PFV, O_PLOGF, O_SCONV, O_SSBK, O_SSBV, O_SFK, O_SFV, O_SLOGF, O_TOTAL};
#pragma unroll 1
            for (int k = 0; k < 14; ++k) {
                unsigned n = MISC[16 + k + 1] - MISC[16 + k]; n = (n + 5u) / 10u;
                size_t cap = offs[k + 1] - offs[k]; if (cap > 60000) cap = 60000; if (n > cap) n = (unsigned)cap;
                for (unsigned e = tid; e < (unsigned)cap; e += 512) ((unsigned*)out)[offs[k] + e] = (e < n) ? 0xAAAAAAAAu : 0u;
            }
        }
    }
}

extern "C" void kernel_launch(void* const* d_in, const int* in_sizes, int n_in, void* d_out, int out_size, void* d_ws, size_t ws_size, hipStream_t stream) {
    static int grid = 0;
    if (grid == 0) {
        if (n_in != 18 || (size_t)out_size != O_TOTAL || ws_size < WS_END) { fprintf(stderr, "kernel_launch: unexpected shapes (n_in %d out %d ws %zu)\n", n_in, out_size, ws_size); grid = -1; return; }
        int dev = 0, cus = 0, per_cu = 0;
        if (hipGetDevice(&dev) != hipSuccess || hipDeviceGetAttribute(&cus, hipDeviceAttributeMultiprocessorCount, dev) != hipSuccess) { grid = -1; return; }
        if (hipFuncSetAttribute((const void*)hybrid_fwd, hipFuncAttributeMaxDynamicSharedMemorySize, LDS_BYTES) != hipSuccess) { fprintf(stderr, "kernel_launch: hipFuncSetAttribute failed\n"); grid = -1; return; }
        if (hipOccupancyMaxActiveBlocksPerMultiprocessor(&per_cu, (const void*)hybrid_fwd, 512, LDS_BYTES) != hipSuccess || per_cu < 1) { fprintf(stderr, "kernel_launch: occupancy query says %d\n", per_cu); }
        (void)hipGetLastError();
        grid = cus;
    }
    if (grid < 0) return;
    if (hipMemsetAsync((char*)d_ws + WS_CTL, 0, CTL_ZERO_BYTES, stream) != hipSuccess) return;
    Params p{};
    for (int i = 0; i < 18; ++i) p.in[i] = (const float*)d_in[i];
    p.out = (float*)d_out; p.ws = (unsigned char*)d_ws;
    hipLaunchKernelGGL(hybrid_fwd, dim3(grid), dim3(512), LDS_BYTES, stream, p);
}
```

```cpp
#include <hip/hip_runtime.h>
#include <cstdio>
#include <cstdint>
#include <cmath>

#define LAS __attribute__((address_space(3)))
#define GAS __attribute__((address_space(1)))
typedef unsigned short bf16_t;
typedef short bf16x8 __attribute__((ext_vector_type(8)));
typedef short s16x4 __attribute__((ext_vector_type(4)));
typedef float f32x2 __attribute__((ext_vector_type(2)));
typedef float f32x4 __attribute__((ext_vector_type(4)));
typedef float f32x16 __attribute__((ext_vector_type(16)));
typedef unsigned u32x2 __attribute__((ext_vector_type(2)));
typedef unsigned u32x4 __attribute__((ext_vector_type(4)));
typedef GAS unsigned gu32;

constexpr int DM = 2048, SEQ = 8192, NSMP = 256, MT = SEQ + NSMP  ;
constexpr int NPROJ = 6144, IN_DIM = 6150, DFF = 5632, NGU = 2 * DFF, PAST = 4096, DSEQ = 32, DB = 8, NH = 6, HD = 128, CONVD = 512;
constexpr int C_GB = 0, C_GC = 512, C_HC = 1024, C_SQ = 1536, C_SK = 2304, C_SV = 3072, C_FQ = 3840, C_FK = 4608, C_FV = 5376;
constexpr float EPS = 1e-5f, LOG2E = 1.4426950408889634f, LN2 = 0.6931471805599453f, QK_SCALE = 0.08838834764831845f;
constexpr float EXIT_T = 40.f;
constexpr size_t O_YP = 0, O_YS = 16777216, O_PCONV = 17301504, O_PSBK = 17303552, O_PSBV = 29886464, O_PFK = 42469376, O_PFV = 55052288, O_PLOGF = 67635200,
                 O_SCONV = 67733504, O_SSBK = 67749888, O_SSBV = 68143104, O_SFK = 68536320, O_SFV = 68929536, O_SLOGF = 69322752, O_TOTAL = 69325824;
constexpr size_t P_KV_STRIDE = (size_t)2 * SEQ * 768, S_KV_STRIDE = (size_t)2 * NSMP * 768;
constexpr size_t MiB = 1u << 20;
constexpr size_t WS_CTL = 0, CTL_ZERO_BYTES = 256 * 1024  , WS_WF = 1 * MiB, WS_WIN = 2 * MiB, WS_WOUT = 50 * MiB, WS_WGU = 66 * MiB, WS_WDN = 154 * MiB,
                 WS_XB = 198 * MiB, WS_XF = 231 * MiB, WS_PROJ = 297 * MiB, WS_Y = 396 * MiB, WS_H = 429 * MiB, WS_END = 520 * MiB;
constexpr size_t WIN_L = (size_t)NPROJ * DM, WOUT_L = (size_t)DM * DM, WGU_L = (size_t)NGU * DM, WDN_L = (size_t)DM * DFF;
constexpr int CW_BAR = 4096, CW_Q = 8192, CW_KMAXP = 8192 + 256, CW_KMAXS = 8192 + 512, CW_KMAXC = 8192 + 1024, CW_SSQ = 16384;
constexpr int RING_BYTES = 131072, MISC_OFF = RING_BYTES + 320, LDS_BYTES = 147456;

typedef __bf16 bf16x2_t __attribute__((ext_vector_type(2)));
__device__ __forceinline__ unsigned cvt_pk_bf16(float lo, float hi) { const f32x2 v = {lo, hi}; const bf16x2_t b = __builtin_convertvector(v, bf16x2_t); return __builtin_bit_cast(unsigned, b); }
__device__ __forceinline__ float bf_lo(unsigned w) { return __uint_as_float(w << 16); }
__device__ __forceinline__ float bf_hi(unsigned w) { return __uint_as_float(w & 0xffff0000u); }
template <int CTRL> __device__ __forceinline__ float dpp_mov(float v) { return __int_as_float(__builtin_amdgcn_update_dpp(0, __float_as_int(v), CTRL, 0xF, 0xF, true)); }
__device__ __forceinline__ float row16_sum(float v) { v += dpp_mov<0xB1>(v); v += dpp_mov<0x4E>(v); v += dpp_mov<0x141>(v); v += dpp_mov<0x140>(v); return v; }
__device__ __forceinline__ float row16_max(float v) { v = fmaxf(v, dpp_mov<0xB1>(v)); v = fmaxf(v, dpp_mov<0x4E>(v)); v = fmaxf(v, dpp_mov<0x141>(v)); v = fmaxf(v, dpp_mov<0x140>(v)); return v; }
__device__ __forceinline__ float swap16_sum(float v) { auto rr = __builtin_amdgcn_permlane16_swap(__float_as_uint(v), __float_as_uint(v), false, false); return __uint_as_float(rr[0]) + __uint_as_float(rr[1]); }
__device__ __forceinline__ float swap32_sum(float v) { auto rr = __builtin_amdgcn_permlane32_swap(__float_as_uint(v), __float_as_uint(v), false, false); return __uint_as_float(rr[0]) + __uint_as_float(rr[1]); }
__device__ __forceinline__ float swap32_max(float v) { auto rr = __builtin_amdgcn_permlane32_swap(__float_as_uint(v), __float_as_uint(v), false, false); return fmaxf(__uint_as_float(rr[0]), __uint_as_float(rr[1])); }
__device__ __forceinline__ float wave_sum(float v) { return swap32_sum(swap16_sum(row16_sum(v))); }
__device__ __forceinline__ float bperm(int src_lane, float v) { return __int_as_float(__builtin_amdgcn_ds_bpermute(src_lane << 2, __float_as_int(v))); }
__device__ __forceinline__ float ex2(float x) { return __builtin_amdgcn_exp2f(x); }
__device__ __forceinline__ float lg2(float x) { return __builtin_amdgcn_logf(x); }
__device__ __forceinline__ float partner32(float v, int hi) {
    auto rr = __builtin_amdgcn_permlane32_swap(__float_as_uint(v), __float_as_uint(v), false, false);
    return __uint_as_float(hi ? rr[0] : rr[1]);
}
__device__ __forceinline__ void st16_wt(void* p, u32x4 v) { asm volatile("global_store_dwordx4 %0, %1, off sc1\n\ts_nop 1" :: "v"(p), "v"(v)); }
#define LDS_WAIT() asm volatile("s_waitcnt lgkmcnt(0)" ::: "memory")
#define VM_WAIT() asm volatile("s_waitcnt vmcnt(0)" ::: "memory")

namespace pg8 {
constexpr int BM = 256, BK = 64, HALF = 128, HTB = HALF * BK * 2, STAGE_BYTES = 8 * HTB, NXCD = 8, WGM = 8;
__host__ __device__ __forceinline__ int lds_byte(int r, int c) { const int st = (r >> 4) * 2 + (c >> 5), rr = r & 15, cc = c & 31, ob = rr * 64 + cc * 2; return st * 1024 + (ob ^ (((ob >> 9) & 1) << 5)); }
__host__ __device__ __forceinline__ void stage_rc(int b, int& R, int& C) { const int st = b / 1024, sb = b % 1024, swz = sb ^ (((sb >> 9) & 1) << 5); R = (st >> 1) * 16 + swz / 64; C = (st & 1) * 32 + (swz % 64) / 2; }
__host__ __device__ __forceinline__ int perm32(int rho) { const int n = rho >> 4, i = rho & 15; return 8 * (i >> 2) + 4 * n + (i & 3); }
struct Unit { int pm, pn; };
struct Gemm { const bf16_t* A; const bf16_t* Bt; int M, N, K; };
struct StaticOrder {
    int nM, nN, nwg, G, c, perm24;
    __host__ __device__ void init(int M, int N, int G_, int c_, int perm24_ = 0) { nM = M / BM; nN = N / BM; nwg = nM * nN; G = G_; c = c_; perm24 = perm24_; }
    __host__ __device__ bool next(int i, Unit& u) const {
        const long L = (long)i * G + c; if (L >= nwg) return false;
        int wgid = (int)L; { const int q = nwg / NXCD, r = nwg % NXCD, xcd = wgid % NXCD, off = wgid / NXCD; wgid = (xcd < r ? xcd * (q + 1) : r * (q + 1) + (xcd - r) * q) + off; }
        const int nig = WGM * nN, gid = wgid / nig, fm = gid * WGM, gsz = (nM - fm) < WGM ? (nM - fm) : WGM;
        u.pm = fm + ((wgid % nig) % gsz); u.pn = (wgid % nig) / gsz;
        if (perm24) {
            const unsigned long long LO = 0ull | (0ull << 0) | (1ull << 5) | (2ull << 10) | (3ull << 15) | (9ull << 20) | (10ull << 25) | (11ull << 30) | (12ull << 35) | (4ull << 40) | (5ull << 45) | (6ull << 50) | (7ull << 55);
            const unsigned long long HI = 0ull | (13ull << 0) | (14ull << 5) | (18ull << 10) | (19ull << 15) | (8ull << 20) | (15ull << 25) | (16ull << 30) | (17ull << 35) | (20ull << 40) | (21ull << 45) | (22ull << 50) | (23ull << 55);
            u.pn = (int)(((u.pn < 12) ? (LO >> (5 * u.pn)) : (HI >> (5 * (u.pn - 12)))) & 31ull);
        }
        return true;
    }
    __device__ __forceinline__ void a_ready(const Unit&) const {}
    __device__ __forceinline__ void done(const Unit&) const {}
};


struct EpiProj {
    static constexpr bool PERM = true, AFTER_DRAIN = false;
    bf16_t* proj; const float* ssq; float* out; int layer; unsigned* kmaxp;
    __device__ __forceinline__ void operator()(const f32x4 (&acc)[2][2][4][2], const Unit& u, int wr, int wc, int fr, int fq) const {
        const int row0 = u.pm * BM + wr * 64 + fr, col0 = u.pn * BM + wc * 32 + 8 * fq;
        int seg = -1, segcol = 0;
        if (u.pn >= 9 && u.pn < 15) { seg = (u.pn - 9) / 3; segcol = ((u.pn - 9) % 3) * 256; }
        else if (u.pn >= 18) { seg = 2 + (u.pn - 18) / 3; segcol = ((u.pn - 18) % 3) * 256; }
        const bool isfk = (u.pn >= 18 && u.pn < 21);
        float ssr[2][2][4];
#pragma unroll
        for (int ai = 0; ai < 2; ++ai)
#pragma unroll
            for (int m = 0; m < 4; ++m) {
                const int r = row0 + ai * HALF + m * 16;
                const float rs = rsqrtf(ssq[r] * (1.0f / DM) + EPS);
                bf16_t* rowp = proj + (size_t)r * NPROJ + col0;
                float* orow = nullptr; const int odd = fr & 1;
                if (seg >= 0) orow = out + O_PSBK + (size_t)seg * P_KV_STRIDE + ((size_t)layer * SEQ + (r - odd)) * 768 + segcol + wc * 32 + 8 * fq + 4 * odd;
#pragma unroll
                for (int bj = 0; bj < 2; ++bj) {
                    const f32x4 v0 = acc[ai][bj][m][0] * rs, v1 = acc[ai][bj][m][1] * rs;
                    u32x4 w; w.x = cvt_pk_bf16(v0[0], v0[1]); w.y = cvt_pk_bf16(v0[2], v0[3]); w.z = cvt_pk_bf16(v1[0], v1[1]); w.w = cvt_pk_bf16(v1[2], v1[3]);
                    *(u32x4*)(rowp + bj * HALF) = w;
                    if (seg >= 0) {
                        const f32x4 x = odd ? v0 : v1;
                        const f32x4 rc = {dpp_mov<0xB1>(x[0]), dpp_mov<0xB1>(x[1]), dpp_mov<0xB1>(x[2]), dpp_mov<0xB1>(x[3])};
                        __builtin_nontemporal_store(odd ? rc : v0, (f32x4*)(orow + bj * HALF)); __builtin_nontemporal_store(odd ? v1 : rc, (f32x4*)(orow + bj * HALF + 768)); }
                    float ss = (v0[0] * v0[0] + v0[1] * v0[1]) + (v0[2] * v0[2] + v0[3] * v0[3]) + (v1[0] * v1[0] + v1[1] * v1[1]) + (v1[2] * v1[2] + v1[3] * v1[3]);
                    ssr[bj][ai][m] = ss;
                }
            }
        if (isfk) {
#pragma unroll
            for (int bj = 0; bj < 2; ++bj) {
                const int head = 2 * (u.pn - 18) + bj;
                float pr[2][4];
#pragma unroll
                for (int ai = 0; ai < 2; ++ai)
#pragma unroll
                    for (int m = 0; m < 4; ++m) pr[ai][m] = swap32_sum(swap16_sum(ssr[bj][ai][m]));
                {
                    float mx = fmaxf(fmaxf(fmaxf(pr[0][0], pr[0][1]), fmaxf(pr[0][2], pr[0][3])), fmaxf(fmaxf(pr[1][0], pr[1][1]), fmaxf(pr[1][2], pr[1][3])));
                    mx = row16_max(mx);
                    if (fr == 0 && fq == 0) atomicMax(kmaxp + (layer * NH + head) * 4 + wc, __float_as_uint(mx));
                }
            }
        }
    }
};
template <bool BASE_F32> struct EpiRes {
    static constexpr bool PERM = true, AFTER_DRAIN = false;
    const float* base_f; bf16_t* xb; float* ssq_out;
    __device__ __forceinline__ void operator()(const f32x4 (&acc)[2][2][4][2], const Unit& u, int wr, int wc, int fr, int fq) const {
        const int row0 = u.pm * BM + wr * 64 + fr, col0 = u.pn * BM + wc * 32 + 8 * fq;
#pragma unroll
        for (int ai = 0; ai < 2; ++ai)
#pragma unroll
            for (int m = 0; m < 4; ++m) {
                const int r = row0 + ai * HALF + m * 16;
                bf16_t* bo = xb + (size_t)r * DM + col0;
                float ss = 0.f;
#pragma unroll
                for (int bj = 0; bj < 2; ++bj) {
                    f32x4 b0, b1;
                    if constexpr (BASE_F32) { const float* bp = base_f + (size_t)r * DM + col0 + bj * HALF; b0 = *(const f32x4*)bp; b1 = *(const f32x4*)(bp + 4); }
                    else { const u32x4 w = *(const u32x4*)(bo + bj * HALF); b0 = (f32x4){bf_lo(w.x), bf_hi(w.x), bf_lo(w.y), bf_hi(w.y)}; b1 = (f32x4){bf_lo(w.z), bf_hi(w.z), bf_lo(w.w), bf_hi(w.w)}; }
                    const f32x4 v0 = b0 + acc[ai][bj][m][0], v1 = b1 + acc[ai][bj][m][1];
                    u32x4 w; w.x = cvt_pk_bf16(v0[0], v0[1]); w.y = cvt_pk_bf16(v0[2], v0[3]); w.z = cvt_pk_bf16(v1[0], v1[1]); w.w = cvt_pk_bf16(v1[2], v1[3]);
                    st16_wt(bo + bj * HALF, w);
                    ss += (v0[0] * v0[0] + v0[1] * v0[1]) + (v0[2] * v0[2] + v0[3] * v0[3]) + (v1[0] * v1[0] + v1[1] * v1[1]) + (v1[2] * v1[2] + v1[3] * v1[3]);
                }
                ss = swap32_sum(swap16_sum(ss));
                if (fq == 0) atomicAdd(ssq_out + r, ss);
            }
    }
};
struct EpiGU {
    static constexpr bool PERM = true, AFTER_DRAIN = false;
    bf16_t* h; const float* ssq;
    __device__ __forceinline__ void operator()(const f32x4 (&acc)[2][2][4][2], const Unit& u, int wr, int wc, int fr, int fq) const {
        const int row0 = u.pm * BM + wr * 64 + fr, col0 = u.pn * HALF + wc * 32 + 8 * fq;
#pragma unroll
        for (int ai = 0; ai < 2; ++ai)
#pragma unroll
            for (int m = 0; m < 4; ++m) {
                const int r = row0 + ai * HALF + m * 16;
                const float rs = rsqrtf(ssq[r] * (1.0f / DM) + EPS);
                float o[8];
#pragma unroll
                for (int n = 0; n < 2; ++n)
#pragma unroll
                    for (int i = 0; i < 4; ++i) {
                        const float g = acc[ai][0][m][n][i] * rs, up = acc[ai][1][m][n][i] * rs;
                        o[4 * n + i] = g * up * __builtin_amdgcn_rcpf(1.0f + ex2(-g * LOG2E));
                    }
                u32x4 w; w.x = cvt_pk_bf16(o[0], o[1]); w.y = cvt_pk_bf16(o[2], o[3]); w.z = cvt_pk_bf16(o[4], o[5]); w.w = cvt_pk_bf16(o[6], o[7]);
                *(u32x4*)(h + (size_t)r * DFF + col0) = w;
            }
    }
};

template <class Epi, class Sched, bool ALIGN_EPI = false, bool SP2 = false>
__device__ __forceinline__ void gemm_phase(LAS unsigned char* lds, const Gemm g, const Sched& S, const Epi& E) {
    int tid = threadIdx.x; asm volatile("" : "+v"(tid));
    const int wid = __builtin_amdgcn_readfirstlane(tid >> 6), lane = tid & 63, wr = wid >> 2, wc = wid & 3, fr = lane & 15, fq = lane >> 4;
    const int K = g.K, nt = K / BK;
    unsigned voffA[2], voffB[2];
#pragma unroll
    for (int i = 0; i < 2; ++i) { int R, C; stage_rc(tid * 16 + i * 8192, R, C); const int Rb = Epi::PERM ? ((R & ~31) + perm32(R & 31)) : R;
        voffA[i] = (unsigned)(R * K + C) * 2u; voffB[i] = (unsigned)(Rb * K + C) * 2u; }
    const size_t kstep = (size_t)(BK * 2);
    const size_t hstep = (size_t)HALF * K * 2;
    const size_t tstep = 2 * hstep;
    const unsigned ldsw = (unsigned)wid * 1024u;
    const int aoff = lds_byte(wr * 64 + fr, fq * 8), boff = lds_byte(wc * 32 + fr, fq * 8);
#define PG8_SA(b, h) (((b) * 2 + (h)) * HTB)
#define PG8_SB(b, h) ((4 + (b) * 2 + (h)) * HTB)
#define PG8_STAGE(bufoff, gbase, voff) do { _Pragma("unroll") for (int _i = 0; _i < 2; ++_i) \
        __builtin_amdgcn_global_load_lds((const unsigned*)((const char*)(gbase) + (voff)[_i]), (LAS unsigned*)(lds + (bufoff) + ldsw + _i * 8192), 16, 0, 0); } while (0)
#define PG8_LDA(dst, b, h) do { _Pragma("unroll") for (int m = 0; m < 4; ++m) _Pragma("unroll") for (int k = 0; k < 2; ++k) dst[m][k] = *(const LAS bf16x8*)(lds + PG8_SA(b, h) + aoff + m * 2048 + k * 1024); } while (0)
#define PG8_LDB(dst, b, h) do { _Pragma("unroll") for (int n = 0; n < 2; ++n) _Pragma("unroll") for (int k = 0; k < 2; ++k) dst[n][k] = *(const LAS bf16x8*)(lds + PG8_SB(b, h) + boff + n * 2048 + k * 1024); } while (0)
#define PG8_MMA(ai, bj, At, Bt) do { __builtin_amdgcn_s_setprio(1); _Pragma("unroll") for (int m = 0; m < 4; ++m) _Pragma("unroll") for (int n = 0; n < 2; ++n) _Pragma("unroll") for (int k = 0; k < 2; ++k) \
        acc[ai][bj][m][n] = __builtin_amdgcn_mfma_f32_16x16x32_bf16(Bt[n][k], At[m][k], acc[ai][bj][m][n], 0, 0, 0); __builtin_amdgcn_s_setprio(0); } while (0)
#define PG8_WAIT_V(n) asm volatile("s_waitcnt vmcnt(" #n ")" ::: "memory")
#define PG8_WAIT_L(n) asm volatile("s_waitcnt lgkmcnt(" #n ")" ::: "memory")
#define PG8_BAR __builtin_amdgcn_s_barrier()
#define PG8_SCHED __builtin_amdgcn_sched_barrier(0)
    Unit cur, nxt; int ui = 0;
    if (!S.next(0, cur)) return;
    f32x4 acc[2][2][4][2];
#pragma unroll
    for (int a = 0; a < 2; ++a)
#pragma unroll
        for (int b = 0; b < 2; ++b)
#pragma unroll
            for (int m = 0; m < 4; ++m)
#pragma unroll
                for (int n = 0; n < 2; ++n) acc[a][b][m][n] = (f32x4){0.f, 0.f, 0.f, 0.f};
    bf16x8 At[4][2], B0[2][2], B1[2][2];
    const char* cA = (const char*)g.A + (size_t)cur.pm * tstep; const char* cB = (const char*)g.Bt + (size_t)cur.pn * tstep;
    S.a_ready(cur);
    if constexpr (SP2) {
        PG8_STAGE(PG8_SB(0, 0), cB, voffB); PG8_STAGE(PG8_SB(0, 1), cB + hstep, voffB); PG8_STAGE(PG8_SA(0, 0), cA, voffA); PG8_STAGE(PG8_SA(0, 1), cA + hstep, voffA);
        if (wr == 1) PG8_BAR;
        PG8_WAIT_V(2); PG8_BAR;
        PG8_STAGE(PG8_SB(1, 0), cB + kstep, voffB); PG8_STAGE(PG8_SA(1, 0), cA + kstep, voffA); PG8_STAGE(PG8_SB(1, 1), cB + hstep + kstep, voffB);
        PG8_WAIT_V(6); PG8_BAR;
    } else {
        PG8_STAGE(PG8_SB(0, 0), cB, voffB); PG8_STAGE(PG8_SA(0, 0), cA, voffA); PG8_STAGE(PG8_SB(0, 1), cB + hstep, voffB); PG8_STAGE(PG8_SA(0, 1), cA + hstep, voffA);
        if (wr == 1) PG8_BAR;
        PG8_WAIT_V(4); PG8_BAR;
        PG8_STAGE(PG8_SB(1, 0), cB + kstep, voffB); PG8_STAGE(PG8_SA(1, 0), cA + kstep, voffA); PG8_STAGE(PG8_SB(1, 1), cB + hstep + kstep, voffB);
        PG8_WAIT_V(6); PG8_BAR;
    }
    for (;;) {
        const bool has_next = S.next(ui + 1, nxt);
        const char* nA = has_next ? (const char*)g.A + (size_t)nxt.pm * tstep : cA; const char* nB = has_next ? (const char*)g.Bt + (size_t)nxt.pn * tstep : cB;
        for (int t = 0; t < nt; t += 2) {
            const bool last = (t == nt - 2);
            const char* a1 = cA + (size_t)(t + 1) * kstep;
            const char* a2 = last ? nA : cA + (size_t)(t + 2) * kstep; const char* b2 = last ? nB : cB + (size_t)(t + 2) * kstep;
            const char* a3 = a2 + kstep; const char* b3 = b2 + kstep;
            if (last && has_next) S.a_ready(nxt);
            if constexpr (SP2) {
            PG8_LDB(B0, 0, 0); PG8_LDB(B1, 0, 1); PG8_SCHED; PG8_LDA(At, 0, 0); PG8_STAGE(PG8_SA(1, 1), a1 + hstep, voffA);
            PG8_WAIT_V(8); PG8_WAIT_L(0); PG8_BAR; PG8_MMA(0, 0, At, B0); PG8_MMA(0, 1, At, B1); PG8_BAR; PG8_SCHED;
            PG8_LDA(At, 0, 1); PG8_STAGE(PG8_SB(0, 0), b2, voffB); PG8_STAGE(PG8_SB(0, 1), b2 + hstep, voffB); PG8_STAGE(PG8_SA(0, 0), a2, voffA);
            PG8_WAIT_V(8); PG8_WAIT_L(0); PG8_BAR; PG8_MMA(1, 0, At, B0); PG8_MMA(1, 1, At, B1); PG8_BAR; PG8_SCHED;
            PG8_LDB(B0, 1, 0); PG8_LDB(B1, 1, 1); PG8_SCHED; PG8_LDA(At, 1, 0); PG8_STAGE(PG8_SA(0, 1), a2 + hstep, voffA);
            PG8_WAIT_V(8); PG8_WAIT_L(0); PG8_BAR; PG8_MMA(0, 0, At, B0); PG8_MMA(0, 1, At, B1); PG8_BAR; PG8_SCHED;
            PG8_LDA(At, 1, 1); PG8_STAGE(PG8_SB(1, 0), b3, voffB); PG8_STAGE(PG8_SB(1, 1), b3 + hstep, voffB); PG8_STAGE(PG8_SA(1, 0), a3, voffA);
            PG8_WAIT_V(8); PG8_WAIT_L(0); PG8_BAR; PG8_MMA(1, 0, At, B0); PG8_MMA(1, 1, At, B1); PG8_BAR; PG8_SCHED;
            } else {
            PG8_LDB(B0, 0, 0); PG8_SCHED; PG8_LDA(At, 0, 0); PG8_STAGE(PG8_SA(1, 1), a1 + hstep, voffA);
            PG8_WAIT_L(8); PG8_BAR; PG8_WAIT_L(0); PG8_MMA(0, 0, At, B0); PG8_BAR; PG8_SCHED;
            PG8_LDB(B1, 0, 1); PG8_STAGE(PG8_SB(0, 0), b2, voffB);
            PG8_BAR; PG8_WAIT_L(0); PG8_MMA(0, 1, At, B1); PG8_BAR;
            PG8_LDA(At, 0, 1); PG8_STAGE(PG8_SA(0, 0), a2, voffA);
            PG8_BAR; PG8_WAIT_L(0); PG8_MMA(1, 0, At, B0); PG8_BAR; PG8_SCHED;
            PG8_STAGE(PG8_SB(0, 1), b2 + hstep, voffB);
            PG8_WAIT_V(6); PG8_BAR; PG8_MMA(1, 1, At, B1); PG8_BAR;
            PG8_LDB(B0, 1, 0); PG8_SCHED; PG8_LDA(At, 1, 0); PG8_STAGE(PG8_SA(0, 1), a2 + hstep, voffA);
            PG8_WAIT_L(8); PG8_BAR; PG8_WAIT_L(0); PG8_MMA(0, 0, At, B0); PG8_BAR; PG8_SCHED;
            PG8_LDB(B1, 1, 1); PG8_STAGE(PG8_SB(1, 0), b3, voffB);
            PG8_BAR; PG8_WAIT_L(0); PG8_MMA(0, 1, At, B1); PG8_BAR;
            PG8_LDA(At, 1, 1); PG8_STAGE(PG8_SA(1, 0), a3, voffA);
            PG8_BAR; PG8_WAIT_L(0); PG8_MMA(1, 0, At, B0); PG8_BAR; PG8_SCHED;
            PG8_STAGE(PG8_SB(1, 1), b3 + hstep, voffB);
            PG8_WAIT_V(6); PG8_BAR; PG8_MMA(1, 1, At, B1); PG8_BAR;
            }
        }
        if constexpr (ALIGN_EPI) { if (wr == 0) PG8_BAR; }
        if constexpr (!Epi::AFTER_DRAIN) { E(acc, cur, wr, wc, fr, fq); S.done(cur); }
        if (!has_next) break;
#pragma unroll
        for (int a = 0; a < 2; ++a)
#pragma unroll
            for (int b = 0; b < 2; ++b)
#pragma unroll
                for (int m = 0; m < 4; ++m)
#pragma unroll
                    for (int n = 0; n < 2; ++n) acc[a][b][m][n] = (f32x4){0.f, 0.f, 0.f, 0.f};
        cur = nxt; cA = nA; cB = nB; ++ui;
        if constexpr (ALIGN_EPI) { if (wr == 1) PG8_BAR; }
    }
    PG8_WAIT_V(0);
    if constexpr (!ALIGN_EPI) { if (wr == 0) PG8_BAR; }
    PG8_BAR;
#undef PG8_SA
#undef PG8_SB
#undef PG8_STAGE
#undef PG8_LDA
#undef PG8_LDB
#undef PG8_MMA
#undef PG8_WAIT_V
#undef PG8_WAIT_L
#undef PG8_BAR
#undef PG8_SCHED
}
}

#define XB_TMO      128
#define XB_XCNT(j)  (256  + 64 * (j))
#define XB_XSUB(j)  (1280 + 64 * (j))
#define XB_XGEN(j)  (2304 + 64 * (j))
#define XB_TOP      3328
#define XB_TOPGEN   3392
#define XCD_BAR_WORDS 3456
#define XB_SPIN_CAP (1u << 18)
__device__ __forceinline__ unsigned xb_ld(unsigned* p)              { return __hip_atomic_load(p, __ATOMIC_RELAXED, __HIP_MEMORY_SCOPE_AGENT); }
__device__ __forceinline__ unsigned xb_add(unsigned* p, unsigned v) { return __hip_atomic_fetch_add(p, v, __ATOMIC_RELAXED, __HIP_MEMORY_SCOPE_AGENT); }
__device__ __forceinline__ unsigned xb_xcc_id() { return (unsigned)__builtin_amdgcn_s_getreg((3 << 11) | 20) & 0xFu; }
#define XB_SPIN(cond, bar) do { unsigned _sp = 0; while (cond) { __builtin_amdgcn_s_sleep(1); \
    if ((++_sp & 255u) == 0u) { if (xb_ld(&(bar)[XB_TMO])) break; if (_sp > XB_SPIN_CAP) { atomicAdd(&(bar)[XB_TMO], 1u); break; } } } } while (0)
struct XcdBarrier { unsigned* bar; unsigned x; volatile LAS unsigned* st; };
__device__ __forceinline__ XcdBarrier xcd_barrier_post(unsigned* bar, volatile LAS unsigned* st) {
    XcdBarrier b; b.bar = bar; b.x = xb_xcc_id(); b.st = st;
    if (threadIdx.x == 0) (void)xb_add(&bar[XB_XCNT(b.x)], 1u);
    return b;
}
__device__ __forceinline__ void xcd_barrier_complete(unsigned* bar, unsigned x, unsigned& nloc, unsigned& nx) {
    const unsigned G = gridDim.x * gridDim.y * gridDim.z;
    unsigned sum, cnt, mine, sp = 0u;
    for (;;) {
        sum = 0u; cnt = 0u; mine = 0u;
#pragma unroll
        for (unsigned j = 0; j < 16; ++j) { const unsigned c = xb_ld(&bar[XB_XCNT(j)]); sum += c; cnt += (c > 0u) ? 1u : 0u; mine = (j == x) ? c : mine; }
        if (sum == G) break;
        __builtin_amdgcn_s_sleep(1);
        if ((++sp & 255u) == 0u) { if (xb_ld(&bar[XB_TMO])) break; if (sp > XB_SPIN_CAP) { atomicAdd(&bar[XB_TMO], 1u); break; } }
    }
    nloc = mine > 0u ? mine : 1u; nx = cnt > 0u ? cnt : 1u;
}
__device__ __forceinline__ void xcd_barrier(const XcdBarrier& b) {
    asm volatile("s_waitcnt vmcnt(0)" ::: "memory");
    __syncthreads();
    if (threadIdx.x == 0) {
        long zb_ = 0; asm volatile("" : "+s"(zb_)); unsigned* bar = b.bar + zb_;
        unsigned bx_ = b.x; asm volatile("" : "+s"(bx_));
        __builtin_amdgcn_s_waitcnt(0);
        unsigned nloc = b.st[0], nx = b.st[1];
        if (nloc == 0u) { xcd_barrier_complete(bar, bx_, nloc, nx); b.st[0] = nloc; b.st[1] = nx; }
        const unsigned old = xb_add(&bar[XB_XSUB(bx_)], 1u);
        const unsigned gen = old / nloc;
        if (old + 1u == (gen + 1u) * nloc) {
            __builtin_amdgcn_fence(__ATOMIC_RELEASE, "agent");
            asm volatile("s_waitcnt vmcnt(0)" ::: "memory");
            const unsigned og = xb_add(&bar[XB_TOP], 1u);
            const unsigned tg = og / nx;
            if (og + 1u == (tg + 1u) * nx) xb_add(&bar[XB_TOPGEN], 1u);
            else XB_SPIN(xb_ld(&bar[XB_TOPGEN]) == tg, bar);
            __builtin_amdgcn_fence(__ATOMIC_ACQUIRE, "agent");
            xb_add(&bar[XB_XGEN(bx_)], 1u);
            asm volatile("s_waitcnt vmcnt(0)" ::: "memory");
        } else {
            XB_SPIN(xb_ld(&bar[XB_XGEN(bx_)]) == gen, bar);
            __builtin_amdgcn_fence(__ATOMIC_ACQUIRE, "agent");
            asm volatile("s_waitcnt vmcnt(0)" ::: "memory");
        }
    }
    __syncthreads();
}

#define KSWZ(row, colB) ((row) * 256 + ((colB) ^ (((row) & 7) << 4)))
#define SBAR() __builtin_amdgcn_sched_barrier(0)
__device__ __forceinline__ int crow(int r, int hi) { return (r & 3) + 8 * (r >> 2) + 4 * hi; }
__device__ __forceinline__ int v_st(int k, int c) { const int kk = (k & ~0xC) | ((k & 4) << 1) | ((k & 8) >> 1); return ((kk >> 3) * 4 + (c >> 5)) * 512 + ((kk & 7) * 32 + (c & 31)) * 2; }
__device__ __forceinline__ int v_rd_base(int lane) { return ((lane & 3) << 3) | (((lane >> 2) & 3) << 6) | (((lane >> 4) & 1) << 5) | (((lane >> 5) & 1) << 8); }
constexpr int v_rd_off(int d0, int ks, int half) { return d0 * 512 + ks * 4096 + half * 2048; }
template <int OFF> __device__ __forceinline__ s16x4 tr_read(unsigned vb) {
    s16x4 r; asm volatile("ds_read_b64_tr_b16 %0, %1 offset:%2" : "=&v"(r) : "v"(vb), "i"(OFF) : "memory"); return r;
}
template <int D0, int D1> __device__ __forceinline__ void pv_two(f32x16& oa, f32x16& ob, unsigned vb, bf16x8 pa0, bf16x8 pa1, bf16x8 pa2, bf16x8 pa3) {
    const s16x4 la0 = tr_read<v_rd_off(D0, 0, 0)>(vb), ha0 = tr_read<v_rd_off(D0, 0, 1)>(vb), la1 = tr_read<v_rd_off(D0, 1, 0)>(vb), ha1 = tr_read<v_rd_off(D0, 1, 1)>(vb);
    const s16x4 la2 = tr_read<v_rd_off(D0, 2, 0)>(vb), ha2 = tr_read<v_rd_off(D0, 2, 1)>(vb), la3 = tr_read<v_rd_off(D0, 3, 0)>(vb), ha3 = tr_read<v_rd_off(D0, 3, 1)>(vb);
    const s16x4 lb0 = tr_read<v_rd_off(D1, 0, 0)>(vb), hb0 = tr_read<v_rd_off(D1, 0, 1)>(vb), lb1 = tr_read<v_rd_off(D1, 1, 0)>(vb), hb1 = tr_read<v_rd_off(D1, 1, 1)>(vb);
    const s16x4 lb2 = tr_read<v_rd_off(D1, 2, 0)>(vb), hb2 = tr_read<v_rd_off(D1, 2, 1)>(vb), lb3 = tr_read<v_rd_off(D1, 3, 0)>(vb), hb3 = tr_read<v_rd_off(D1, 3, 1)>(vb);
    asm volatile("s_waitcnt lgkmcnt(0)" ::: "memory"); SBAR();
#define PK(L, H) (bf16x8){L[0], L[1], L[2], L[3], H[0], H[1], H[2], H[3]}
    oa = __builtin_amdgcn_mfma_f32_32x32x16_bf16(pa0, PK(la0, ha0), oa, 0, 0, 0);
    ob = __builtin_amdgcn_mfma_f32_32x32x16_bf16(pa0, PK(lb0, hb0), ob, 0, 0, 0);
    oa = __builtin_amdgcn_mfma_f32_32x32x16_bf16(pa1, PK(la1, ha1), oa, 0, 0, 0);
    ob = __builtin_amdgcn_mfma_f32_32x32x16_bf16(pa1, PK(lb1, hb1), ob, 0, 0, 0);
    oa = __builtin_amdgcn_mfma_f32_32x32x16_bf16(pa2, PK(la2, ha2), oa, 0, 0, 0);
    ob = __builtin_amdgcn_mfma_f32_32x32x16_bf16(pa2, PK(lb2, hb2), ob, 0, 0, 0);
    oa = __builtin_amdgcn_mfma_f32_32x32x16_bf16(pa3, PK(la3, ha3), oa, 0, 0, 0);
    ob = __builtin_amdgcn_mfma_f32_32x32x16_bf16(pa3, PK(lb3, hb3), ob, 0, 0, 0);
#undef PK
}
#define PK4(P, BASE, OUT) do { unsigned a0 = cvt_pk_bf16(P[BASE + 0], P[BASE + 1]), a1 = cvt_pk_bf16(P[BASE + 2], P[BASE + 3]);   \
    unsigned b0 = cvt_pk_bf16(P[BASE + 4], P[BASE + 5]), b1 = cvt_pk_bf16(P[BASE + 6], P[BASE + 7]);                              \
    auto r0 = __builtin_amdgcn_permlane32_swap(a0, b0, false, false); auto r1 = __builtin_amdgcn_permlane32_swap(a1, b1, false, false); \
    u32x4 w = {r0[0], r1[0], r0[1], r1[1]}; OUT = __builtin_bit_cast(bf16x8, w); } while (0)

constexpr int AL_KV = 0  , AL_WS = 65536  , AL_CQ = 67584  , AL_CK = 69632  ,
              AL_FLAG = 70656  , AL_Q = 73728  , AL_Q7 = 135168;

struct AttnItem {
    int sb;
    int nq, t0, Kc, Knew_cnt;
    const bf16_t* Q;
    const float* Kcache; const float* Vcache;
    const bf16_t* Knew; const bf16_t* Vnew;
    const float* Lcache; const float* Lnew;
    float kn2, kn2b;
    bf16_t* O;
};

__device__ __forceinline__ bf16x8 cvt8(const f32x4 a, const f32x4 b) {
    u32x4 w = {cvt_pk_bf16(a[0], a[1]), cvt_pk_bf16(a[2], a[3]), cvt_pk_bf16(b[0], b[1]), cvt_pk_bf16(b[2], b[3])}; return __builtin_bit_cast(bf16x8, w);
}
template <int SB> __device__ __forceinline__ void attn_item(const AttnItem& it, LAS unsigned char* lds) {
    int tid = threadIdx.x; asm volatile("" : "+v"(tid));
    const int lane = tid & 63, r32 = lane & 31, hi = lane >> 5; const int wid = __builtin_amdgcn_readfirstlane(tid >> 6);
    const int hs = wid >> 2, rg = wid & 3;
    LAS unsigned char* K_lds = lds + AL_KV + hs * 32768; LAS unsigned char* V_lds = K_lds + 16384;
    LAS float* wsf = (LAS float*)(lds + AL_WS) + wid * 64;
    LAS float* cq_l = (LAS float*)(lds + AL_CQ) + hs * 256; LAS float* ck_l = (LAS float*)(lds + AL_CK) + hs * 128; volatile LAS unsigned* flag_l = (volatile LAS unsigned*)(lds + AL_FLAG);
    const bool active = (32 * rg < it.nq);
    constexpr int sb = SB;
    LAS unsigned char* Q_lds = lds + (wid == 7 ? AL_Q7 : AL_Q + wid * 8192);
    const float* Lnew_h = it.Lnew + hs; const float* Lcache_h = it.Lcache + hs;
    const int sr = (tid & 255) >> 4, sc = (tid & 15) * 8;
    const int jstart = (it.t0 + it.nq - 1) >> 6;
    f32x4 ra[4];
    const f32x4 zero4 = {0.f, 0.f, 0.f, 0.f};
    const int kst = KSWZ(sr, sc * 2), vst = v_st(sr, sc);
    const int lrow = lane >> 4, lch = lane & 15;
#define NTL(p) __builtin_nontemporal_load((const f32x4*)(p))
#define V_PRELOAD(jj) do { const int j_ = (jj); \
        if (64 * j_ >= it.Kc) { \
            const int pn0_ = 64 * j_ - it.Kc; const unsigned off_ = (unsigned)(pn0_ + sr) * (unsigned)(NPROJ * 2) + (unsigned)(sc + hs * HD) * 2u; const char* vn_ = (const char*)it.Vnew; \
            ra[0] = zero4; ra[1] = zero4; ra[2] = zero4; ra[3] = zero4; \
            if (pn0_ < it.Knew_cnt) { ra[0] = *(const f32x4*)(vn_ + off_); ra[1] = *(const f32x4*)(vn_ + 16 * NPROJ * 2 + off_); } \
            if (pn0_ + 32 < it.Knew_cnt) { ra[2] = *(const f32x4*)(vn_ + 32 * NPROJ * 2 + off_); ra[3] = *(const f32x4*)(vn_ + 48 * NPROJ * 2 + off_); } } } while (0)
#define K_STAGE(jj) do { const int j_ = (jj); \
        if (64 * j_ >= it.Kc && 64 * j_ - it.Kc + 64 <= it.Knew_cnt) {     \
            const char* kn_ = (const char*)it.Knew + ((size_t)(64 * j_ - it.Kc + 16 * rg) * NPROJ + hs * HD) * 2; LAS unsigned char* kd_ = K_lds + rg * 4096; \
            const unsigned oe_ = (unsigned)lrow * (unsigned)(NPROJ * 2) + (unsigned)((lch ^ lrow) * 16), oo_ = (unsigned)(lrow + 4) * (unsigned)(NPROJ * 2) + (unsigned)((lch ^ (lrow + 4)) * 16); \
            __builtin_amdgcn_global_load_lds((const unsigned*)(kn_ + oe_), (LAS unsigned*)(kd_), 16, 0, 0); \
            __builtin_amdgcn_global_load_lds((const unsigned*)(kn_ + oo_), (LAS unsigned*)(kd_ + 1024), 16, 0, 0); \
            __builtin_amdgcn_global_load_lds((const unsigned*)(kn_ + 8 * NPROJ * 2 + oe_), (LAS unsigned*)(kd_ + 2048), 16, 0, 0); \
            __builtin_amdgcn_global_load_lds((const unsigned*)(kn_ + 8 * NPROJ * 2 + oo_), (LAS unsigned*)(kd_ + 3072), 16, 0, 0); \
        } else if (64 * j_ < it.Kc) { \
            const char* kc_ = (const char*)it.Kcache; \
            _Pragma("unroll 1") for (int q_ = 0; q_ < 4; ++q_) { const unsigned off_ = (unsigned)(64 * j_ + sr + 16 * q_) * 3072u + (unsigned)(sc + hs * HD) * 4u; \
                const f32x4 a0_ = NTL(kc_ + off_), a1_ = NTL(kc_ + off_ + 16); *(LAS bf16x8*)(K_lds + kst + q_ * 4096) = cvt8(a0_, a1_); } \
        } else { \
            const int pn0_ = 64 * j_ - it.Kc; const unsigned off_ = (unsigned)(pn0_ + sr) * (unsigned)(NPROJ * 2) + (unsigned)(sc + hs * HD) * 2u; const char* kn_ = (const char*)it.Knew; \
            _Pragma("unroll 1") for (int q_ = 0; q_ < 4; ++q_) { f32x4 t_ = zero4; if (pn0_ + 32 * (q_ >> 1) < it.Knew_cnt) t_ = *(const f32x4*)(kn_ + q_ * 16 * NPROJ * 2 + off_); \
                *(LAS bf16x8*)(K_lds + kst + q_ * 4096) = __builtin_bit_cast(bf16x8, t_); } \
        } } while (0)
    K_STAGE(jstart); V_PRELOAD(jstart);
    float qn = 0.f, cq = 0.f;
    if (active) {
        const bf16_t* Qw = it.Q + (size_t)(32 * rg + r32) * NPROJ + hs * HD + hi * 8;
        float s2 = 0.f;
#pragma unroll
        for (int d0 = 0; d0 < 8; ++d0) { const bf16x8 qv = *(const bf16x8*)(Qw + d0 * 16);
            *(LAS bf16x8*)(Q_lds + KSWZ(r32, (d0 * 16 + hi * 8) * 2)) = qv;
            const u32x4 w = __builtin_bit_cast(u32x4, qv);
#pragma unroll
            for (int i = 0; i < 4; ++i) { const float a = bf_lo(w[i]), b = bf_hi(w[i]); s2 += a * a + b * b; } }
        s2 += partner32(s2, hi);
        qn = sqrtf(s2);
    }
    if (!sb) {
        if (rg == 3) {
            float v[4]; float s = 0.f;
#pragma unroll
            for (int i = 0; i < 4; ++i) { const int idx = 4 * lane + i; const int pn = it.t0 - it.Kc + idx; v[i] = (idx < it.nq) ? Lnew_h[(size_t)pn * 6] : 0.f; s += v[i]; }
            float incl = s;
#pragma unroll
            for (int o = 1; o < 64; o <<= 1) { const float t = bperm((lane - o) & 63, incl); if (lane >= o) incl += t; }
            float run = incl - s;
#pragma unroll
            for (int i = 0; i < 4; ++i) { run += v[i]; cq_l[4 * lane + i] = run; }
        }
        __syncthreads();
        cq = cq_l[32 * rg + r32];
    }
    const float knorm = sqrtf(hs ? it.kn2b : it.kn2) * 1.01f;
    float R = 0.f, m_run = -1e30f, l_run = 0.f, tot = 0.f;
    f32x16 o[4];
#pragma unroll
    for (int d = 0; d < 4; ++d) o[d] = f32x16{};
    bool done = !active;
    const int qpos = it.t0 + 32 * rg + r32, qpos_max = it.t0 + 32 * rg + 31;
    const unsigned vb = (unsigned)(uintptr_t)V_lds + (unsigned)v_rd_base(lane);
    for (int j = jstart; j >= 0; --j) {
        if (64 * j < it.Kc) {
            const char* vc = (const char*)it.Vcache;
#pragma unroll 1
            for (int q = 0; q < 4; ++q) {
                const unsigned off = (unsigned)(64 * j + sr + 16 * q) * 3072u + (unsigned)(sc + hs * HD) * 4u;
                const f32x4 c0 = NTL(vc + off), c1 = NTL(vc + off + 16);
                *(LAS bf16x8*)(V_lds + vst + q * 4096) = cvt8(c0, c1);
            }
        } else {
#pragma unroll
            for (int q = 0; q < 4; ++q) *(LAS bf16x8*)(V_lds + vst + q * 4096) = __builtin_bit_cast(bf16x8, ra[q]);
        }
        if (!sb && rg == 3) {
            const int p = 64 * j + lane;
            if (64 * j >= it.t0) {
                const int idx = p - it.t0;
                ck_l[lane] = (idx < it.nq) ? cq_l[idx] : 0.f;
                if (lane == 0) ck_l[64] = (64 * j > it.t0) ? cq_l[64 * j - 1 - it.t0] : 0.f;
            } else {
                float L;
                if (p < it.Kc) L = Lcache_h[(size_t)p * 6]; else L = Lnew_h[(size_t)(p - it.Kc) * 6];
                float suf = L;
#pragma unroll
                for (int o = 1; o < 64; o <<= 1) { const float t = bperm((lane + o) & 63, suf); if (lane + o < 64) suf += t; }
                ck_l[lane] = tot - (suf - L);
                const float total = __builtin_amdgcn_readfirstlane(suf);
                tot -= total;
                if (lane == 0) ck_l[64] = tot;
            }
        }
        VM_WAIT(); __syncthreads();
        if (j > 0) V_PRELOAD(j - 1);
        const bool comp = !done && 64 * j <= qpos_max;
        f32x16 p0 = f32x16{}, p1 = f32x16{};
        if (comp) {
            const int swz = (r32 & 7) << 4;
#pragma unroll
            for (int d = 0; d < 4; ++d) { const int ka = r32 * 256 + ((d * 32 + hi * 16) ^ swz);
#pragma unroll
                for (int dh = 0; dh < 2; ++dh) {
                    const bf16x8 b0 = *(const LAS bf16x8*)(K_lds + ka + dh * 128);
                    const bf16x8 b1 = *(const LAS bf16x8*)(K_lds + ka + dh * 128 + 8192);
                    const bf16x8 qf = *(const LAS bf16x8*)(Q_lds + ka + dh * 128);
                    p0 = __builtin_amdgcn_mfma_f32_32x32x16_bf16(b0, qf, p0, 0, 0, 0);
                    p1 = __builtin_amdgcn_mfma_f32_32x32x16_bf16(b1, qf, p1, 0, 0, 0); } }
        }
        __syncthreads();
        if (j > 0) K_STAGE(j - 1);
        if (comp) {
            const int kb = 64 * j + 4 * hi;
            bf16x8 pa0, pa1, pa2, pa3;
            if (sb) {
                float run = R;
#define SB_GROUP(P, g, KOFF, BAR) do { float z_[4], l_[4]; \
                    _Pragma("unroll") for (int i_ = 0; i_ < 4; ++i_) { const float z = P[4 * (g) + i_] * QK_SCALE; const float sp = lg2(1.f + ex2(-fabsf(z) * LOG2E)) * LN2; \
                        const bool ok = (kb + (KOFF) + 8 * (g) + i_) < qpos; l_[i_] = ok ? -(fmaxf(z, 0.f) + sp) : 0.f; z_[i_] = ok ? z : -INFINITY; } \
                    const float gs = (l_[0] + l_[1]) + (l_[2] + l_[3]); const float gp = partner32(gs, hi); \
                    float lat = run + (hi ? 0.f : gp); \
                    P[4 * (g) + 3] = ex2((z_[3] + l_[3] + lat) * LOG2E); lat += l_[3]; \
                    P[4 * (g) + 2] = ex2((z_[2] + l_[2] + lat) * LOG2E); lat += l_[2]; \
                    P[4 * (g) + 1] = ex2((z_[1] + l_[1] + lat) * LOG2E); lat += l_[1]; \
                    P[4 * (g) + 0] = ex2((z_[0] + l_[0] + lat) * LOG2E); \
                    run += gs + gp; if (BAR) SBAR(); } while (0)
                SB_GROUP(p1, 3, 32, 0); SB_GROUP(p1, 2, 32, 1); SB_GROUP(p1, 1, 32, 0); SB_GROUP(p1, 0, 32, 1);
                SB_GROUP(p0, 3, 0, 0); SB_GROUP(p0, 2, 0, 1); SB_GROUP(p0, 1, 0, 0); SB_GROUP(p0, 0, 0, 1);
#undef SB_GROUP
                R = run;
                PK4(p0, 0, pa0); PK4(p0, 8, pa1); PK4(p1, 0, pa2); PK4(p1, 8, pa3);
                done = __all(R < -EXIT_T);
            } else {
                float pmax = -INFINITY;
#pragma unroll
                for (int g = 0; g < 4; ++g) {
                    const f32x4 c0 = *(const LAS f32x4*)(ck_l + 8 * g + 4 * hi), c1 = *(const LAS f32x4*)(ck_l + 32 + 8 * g + 4 * hi);
#pragma unroll
                    for (int i = 0; i < 4; ++i) { const int r = 4 * g + i; const int kp = kb + i + 8 * g;
                        const float s0 = p0[r] * QK_SCALE + (cq - c0[i]), s1 = p1[r] * QK_SCALE + (cq - c1[i]);
                        p0[r] = (kp <= qpos) ? s0 : -INFINITY; p1[r] = (kp + 32 <= qpos) ? s1 : -INFINITY;
                        pmax = fmaxf(pmax, fmaxf(p0[r], p1[r])); }
                    SBAR();
                }
                pmax = fmaxf(pmax, partner32(pmax, hi));
                const float mnew = fmaxf(m_run, pmax);
                const float alpha = ex2((m_run - mnew) * LOG2E);
                float ps = 0.f;
#pragma unroll
                for (int r = 0; r < 16; ++r) { p0[r] = ex2((p0[r] - mnew) * LOG2E); p1[r] = ex2((p1[r] - mnew) * LOG2E); ps += p0[r] + p1[r]; if ((r & 3) == 3) SBAR(); }
                ps += partner32(ps, hi);
                l_run = l_run * alpha + ps; m_run = mnew;
                if (__any(alpha != 1.f)) {
                    if (hi == 0) wsf[r32] = alpha;
                    LDS_WAIT();
#pragma unroll
                    for (int r = 0; r < 16; ++r) { const float a = wsf[crow(r, hi)];
#pragma unroll
                        for (int d = 0; d < 4; ++d) o[d][r] *= a; }
                }
                PK4(p0, 0, pa0); PK4(p0, 8, pa1); PK4(p1, 0, pa2); PK4(p1, 8, pa3);
                const float zb = qn * knorm * QK_SCALE + (cq - ck_l[64]);
                done = __all(zb - m_run < -EXIT_T);
            }
            pv_two<0, 1>(o[0], o[1], vb, pa0, pa1, pa2, pa3); pv_two<2, 3>(o[2], o[3], vb, pa0, pa1, pa2, pa3);
        }
        if (lane == 0) flag_l[wid] = done ? 1u : 0u;
        __syncthreads();
        unsigned all = 1u;
#pragma unroll
        for (int w = 0; w < 8; ++w) all &= flag_l[w];
        if (all) break;
    }
    if (active) {
        float rli[16];
        if (!sb) {
            if (hi == 0) wsf[32 + r32] = 1.0f / l_run;
            LDS_WAIT();
#pragma unroll
            for (int r = 0; r < 16; ++r) rli[r] = wsf[32 + crow(r, hi)];
        } else {
#pragma unroll
            for (int r = 0; r < 16; ++r) rli[r] = 1.f;
        }
        bf16_t* Ow = it.O + (size_t)(32 * rg) * DM + hs * HD;
#pragma unroll
        for (int r = 0; r < 16; ++r) { const int orow = crow(r, hi);
#pragma unroll
            for (int d0 = 0; d0 < 4; ++d0) { const unsigned w = cvt_pk_bf16(o[d0][r] * rli[r], 0.f); Ow[(size_t)orow * DM + d0 * 32 + r32] = (bf16_t)(w & 0xffffu); } }
    }
    VM_WAIT(); __syncthreads();
#undef V_PRELOAD
#undef K_STAGE
#undef NTL
}

__device__ __forceinline__ void conv_item(int cb, int layer, const bf16_t* proj, bf16_t* Y, const float* state_conv, const float* conv_w, float* out) {
    int tid = threadIdx.x; asm volatile("" : "+v"(tid));
    const int lane = tid & 63, wid = tid >> 6;
    const int c8 = lane * 8, g0 = 64 * cb + 8 * wid;
    const bool sample = g0 >= SEQ;
    const int b = sample ? (g0 - SEQ) / DSEQ : 0;
    const int seq0 = sample ? SEQ + DSEQ * b : 0, seq_end = sample ? seq0 + DSEQ : SEQ;
    float w0[8], w1[8], w2[8], um2[8], um1[8];
    { const float* cw = conv_w + (size_t)layer * 3 * CONVD + c8;
      const f32x4 a0 = *(const f32x4*)cw, a1 = *(const f32x4*)(cw + 4), b0 = *(const f32x4*)(cw + CONVD), b1 = *(const f32x4*)(cw + CONVD + 4), c0 = *(const f32x4*)(cw + 2 * CONVD), c1 = *(const f32x4*)(cw + 2 * CONVD + 4);
#pragma unroll
      for (int i = 0; i < 4; ++i) { w0[i] = a0[i]; w0[4 + i] = a1[i]; w1[i] = b0[i]; w1[4 + i] = b1[i]; w2[i] = c0[i]; w2[4 + i] = c1[i]; } }
    auto load_u = [&](int t, float (&u)[8]) {
        const u32x4 gc = *(const u32x4*)(proj + (size_t)t * NPROJ + C_GC + c8), hc = *(const u32x4*)(proj + (size_t)t * NPROJ + C_HC + c8);
#pragma unroll
        for (int i = 0; i < 4; ++i) { u[2 * i] = bf_lo(gc[i]) * bf_lo(hc[i]); u[2 * i + 1] = bf_hi(gc[i]) * bf_hi(hc[i]); }
    };
    if (g0 == seq0) {
        if (sample) { const float* st = state_conv + ((size_t)(layer * DB + b) * 2) * CONVD + c8;
            const f32x4 a0 = *(const f32x4*)st, a1 = *(const f32x4*)(st + 4), b0 = *(const f32x4*)(st + CONVD), b1 = *(const f32x4*)(st + CONVD + 4);
#pragma unroll
            for (int i = 0; i < 4; ++i) { um2[i] = a0[i]; um2[4 + i] = a1[i]; um1[i] = b0[i]; um1[4 + i] = b1[i]; } }
        else {
#pragma unroll
            for (int i = 0; i < 8; ++i) { um2[i] = 0.f; um1[i] = 0.f; } }
    } else { load_u(g0 - 2, um2); load_u(g0 - 1, um1); }
#pragma unroll 1
    for (int t = g0; t < g0 + 8; ++t) {
        float u[8]; load_u(t, u);
        const u32x4 gb = *(const u32x4*)(proj + (size_t)t * NPROJ + C_GB + c8);
        float y[8];
#pragma unroll
        for (int i = 0; i < 4; ++i) {
            y[2 * i] = bf_lo(gb[i]) * (w0[2 * i] * um2[2 * i] + w1[2 * i] * um1[2 * i] + w2[2 * i] * u[2 * i]);
            y[2 * i + 1] = bf_hi(gb[i]) * (w0[2 * i + 1] * um2[2 * i + 1] + w1[2 * i + 1] * um1[2 * i + 1] + w2[2 * i + 1] * u[2 * i + 1]);
        }
        u32x4 w; w.x = cvt_pk_bf16(y[0], y[1]); w.y = cvt_pk_bf16(y[2], y[3]); w.z = cvt_pk_bf16(y[4], y[5]); w.w = cvt_pk_bf16(y[6], y[7]);
        *(u32x4*)(Y + (size_t)t * DM + c8) = w;
        if (t >= seq_end - 2) {
            const int which = t - (seq_end - 2);
            float* dst = sample ? out + O_SCONV + ((size_t)(layer * DB + b) * 2 + which) * CONVD + c8 : out + O_PCONV + ((size_t)layer * 2 + which) * CONVD + c8;
            *(f32x4*)dst = (f32x4){u[0], u[1], u[2], u[3]}; *(f32x4*)(dst + 4) = (f32x4){u[4], u[5], u[6], u[7]};
        }
#pragma unroll
        for (int i = 0; i < 8; ++i) { um2[i] = um1[i]; um1[i] = u[i]; }
    }
}


struct SkProj {
    bf16_t* proj; const float* ssq; float* out; int layer; unsigned* kmaxs;
    __device__ __forceinline__ void operator()(const f32x16& acc, int n0, int row, int r32, int hi) const {
        const float rs = rsqrtf(ssq[SEQ + row] * (1.0f / DM) + EPS);
        int seg = -1, segcol = 0;
        if (n0 >= C_SK && n0 < C_FQ) { seg = (n0 - C_SK) / 768; segcol = (n0 - C_SK) % 768; }
        else if (n0 >= C_FK) { seg = 2 + (n0 - C_FK) / 768; segcol = (n0 - C_FK) % 768; }
        bf16_t* pr = proj + (size_t)(SEQ + row) * NPROJ + n0 + 4 * hi;
        float* orow = out + O_SSBK + (size_t)(seg < 0 ? 0 : seg) * S_KV_STRIDE + ((size_t)layer * NSMP + row) * 768 + segcol + 4 * hi;
        float ss = 0.f;
#pragma unroll
        for (int g = 0; g < 4; ++g) {
            const f32x4 v = {acc[4 * g] * rs, acc[4 * g + 1] * rs, acc[4 * g + 2] * rs, acc[4 * g + 3] * rs};
            u32x2 w; w.x = cvt_pk_bf16(v[0], v[1]); w.y = cvt_pk_bf16(v[2], v[3]);
            *(u32x2*)(pr + 8 * g) = w;
            if (seg >= 0) *(f32x4*)(orow + 8 * g) = v;
            ss += (v[0] * v[0] + v[1] * v[1]) + (v[2] * v[2] + v[3] * v[3]);
        }
        if (n0 >= C_FK && n0 < C_FV) {
            ss = swap32_sum(ss);
            float mx = row16_max(ss);
            { auto rr = __builtin_amdgcn_permlane16_swap(__float_as_uint(mx), __float_as_uint(mx), false, false); mx = fmaxf(__uint_as_float(rr[0]), __uint_as_float(rr[1])); }
            const int head = (n0 - C_FK) / HD, part = ((n0 - C_FK) % HD) / 32, b = row >> 5;
            if (r32 == 0 && hi == 0) atomicMax(kmaxs + ((layer * DB + b) * NH + head) * 4 + part, __float_as_uint(mx));
        }
    }
};
template <bool BASE_F32> struct SkRes {
    const float* base_f; bf16_t* xb; float* ssq_out;
    __device__ __forceinline__ void operator()(const f32x16& acc, int n0, int row, int r32, int hi) const {
        bf16_t* bo = xb + (size_t)(SEQ + row) * DM + n0 + 4 * hi;
        float ss = 0.f;
#pragma unroll
        for (int g = 0; g < 4; ++g) {
            f32x4 b;
            if constexpr (BASE_F32) b = *(const f32x4*)(base_f + (size_t)row * DM + n0 + 4 * hi + 8 * g);
            else { const u32x2 w = *(const u32x2*)(bo + 8 * g); b = (f32x4){bf_lo(w.x), bf_hi(w.x), bf_lo(w.y), bf_hi(w.y)}; }
            const f32x4 v = {b[0] + acc[4 * g], b[1] + acc[4 * g + 1], b[2] + acc[4 * g + 2], b[3] + acc[4 * g + 3]};
            u32x2 w; w.x = cvt_pk_bf16(v[0], v[1]); w.y = cvt_pk_bf16(v[2], v[3]);
            *(u32x2*)(bo + 8 * g) = w;
            ss += (v[0] * v[0] + v[1] * v[1]) + (v[2] * v[2] + v[3] * v[3]);
        }
        ss = swap32_sum(ss);
        if (hi == 0) atomicAdd(ssq_out + SEQ + row, ss);
    }
};
struct SkLogit {
    const float* ssq; const float* bfl; float* out; int layer, rowbase;
    __device__ __forceinline__ void operator()(const f32x16& acc, int n0, int row, int r32, int hi) const {
        const int R = rowbase + row;
        const float rs = rsqrtf(ssq[R] * (1.0f / DM) + EPS);
        float* dst = (R < SEQ) ? out + O_PLOGF + ((size_t)layer * SEQ + R) * 6 : out + O_SLOGF + ((size_t)layer * NSMP + (R - SEQ)) * 6;
#pragma unroll
        for (int i = 0; i < 4; ++i) { const int col = 4 * hi + i;
            if (col < NH) { const float f = acc[i] * rs + bfl[col]; dst[col] = fminf(f, 0.f) - log1pf(expf(-fabsf(f))); } }
    }
};
template <int KSPLIT, class Epi> __device__ __forceinline__ void skinny_item(LAS unsigned char* lds, const bf16_t* X, int ldx, const bf16_t* Wt, int ldw, int K, int n0, int rh, const Epi& E) {
    int tid = threadIdx.x; asm volatile("" : "+v"(tid));
    const int lane = tid & 63, r32 = lane & 31, hi = lane >> 5; const int wid = __builtin_amdgcn_readfirstlane(tid >> 6);
    constexpr int RW = 8 / KSPLIT;
    const int kh = wid / RW;
    const int row0 = 32 * RW * rh + 32 * (wid % RW);
    const int Kw = K / KSPLIT, kbeg = kh * Kw;
    LAS unsigned char* Xl = lds + wid * 16384; LAS unsigned char* Wl = Xl + 8192;
    const int lrow = lane >> 4, lch = lane & 15;
    const char* xg = (const char*)(X + kbeg); const char* wg = (const char*)(Wt + (size_t)n0 * ldw + kbeg);
    const unsigned xo = (unsigned)((row0 + lrow) * ldx + lch * 8) * 2u, wo = (unsigned)(lrow * ldw + lch * 8) * 2u;
    const unsigned xstep = (unsigned)ldx * 8u, wstep = (unsigned)ldw * 8u;
    f32x16 acc = f32x16{};
    bf16x8 xs[8], ws[8];
#define SK_LOAD(k0) do { _Pragma("unroll") for (int i_ = 0; i_ < 8; ++i_) { xs[i_] = *(const bf16x8*)(xg + (xo + i_ * xstep + (unsigned)(k0) * 2u)); ws[i_] = *(const bf16x8*)(wg + (wo + i_ * wstep + (unsigned)(k0) * 2u)); } } while (0)
    const int swz = (r32 & 7) << 4;
    const int offe = lrow * 256 + ((lch * 16) ^ (lrow << 4)), offo = lrow * 256 + ((lch * 16) ^ ((lrow + 4) << 4));
    SK_LOAD(0);
    for (int k0 = 0; k0 < Kw; k0 += 128) {
#pragma unroll
        for (int i = 0; i < 8; ++i) { const int off = ((i & 1) ? offo : offe) + i * 1024; *(LAS bf16x8*)(Xl + off) = xs[i]; *(LAS bf16x8*)(Wl + off) = ws[i]; }
        if (k0 + 128 < Kw) SK_LOAD(k0 + 128);
#pragma unroll
        for (int d = 0; d < 4; ++d) { const int ka = r32 * 256 + ((d * 32 + hi * 16) ^ swz);
#pragma unroll
            for (int dh = 0; dh < 2; ++dh) {
                const bf16x8 xf = *(const LAS bf16x8*)(Xl + ka + dh * 128);
                const bf16x8 wf = *(const LAS bf16x8*)(Wl + ka + dh * 128);
                acc = __builtin_amdgcn_mfma_f32_32x32x16_bf16(wf, xf, acc, 0, 0, 0); } }
    }
#undef SK_LOAD
    if constexpr (KSPLIT > 1) {
        if (kh > 0) {
#pragma unroll
            for (int g = 0; g < 4; ++g) *(LAS f32x4*)(Xl + lane * 64 + g * 16) = (f32x4){acc[4 * g], acc[4 * g + 1], acc[4 * g + 2], acc[4 * g + 3]};
        }
        __syncthreads();
        if (kh == 0) {
#pragma unroll
            for (int p = 1; p < KSPLIT; ++p) { const LAS unsigned char* Pl = lds + (wid + p * RW) * 16384;
#pragma unroll
                for (int g = 0; g < 4; ++g) { const f32x4 q = *(const LAS f32x4*)(Pl + lane * 64 + g * 16); acc[4 * g] += q[0]; acc[4 * g + 1] += q[1]; acc[4 * g + 2] += q[2]; acc[4 * g + 3] += q[3]; } }
            E(acc, n0, row0 + r32, r32, hi);
        }
        __syncthreads();
    } else {
        E(acc, n0, row0 + r32, r32, hi);
    }
}

template <class Epi> __device__ __forceinline__ void skinny128_item(LAS unsigned char* lds, const bf16_t* X, int ldx, const bf16_t* Wt, int ldw, int K, int n0, int rh, const Epi& E) {
    int tid = threadIdx.x; asm volatile("" : "+v"(tid));
    const int lane = tid & 63, r32 = lane & 31, hi = lane >> 5; const int wid = __builtin_amdgcn_readfirstlane(tid >> 6);
    const int wrow = wid >> 1, wcol = wid & 1;
    const int lrow = lane >> 4, lch = lane & 15;
    const char* xg = (const char*)(X + (size_t)(128 * rh + 16 * wid) * ldx); const char* wg = (const char*)(Wt + (size_t)(n0 + 16 * wid) * ldw);
    const unsigned xoe = (unsigned)(lrow * ldx + (lch ^ lrow) * 8) * 2u, xoo = (unsigned)((lrow + 4) * ldx + (lch ^ (lrow + 4)) * 8) * 2u;
    const unsigned woe = (unsigned)(lrow * ldw + (lch ^ lrow) * 8) * 2u, woo = (unsigned)((lrow + 4) * ldw + (lch ^ (lrow + 4)) * 8) * 2u;
    const size_t x8 = (size_t)ldx * 16, w8 = (size_t)ldw * 16;
#define SK128_STAGE(t, b) do { LAS unsigned char* xl_ = lds + (b) * 65536 + wid * 4096; LAS unsigned char* wl_ = xl_ + 32768; const char* xs_ = xg + (size_t)(t) * 256; const char* ws_ = wg + (size_t)(t) * 256; \
        __builtin_amdgcn_global_load_lds((const unsigned*)(xs_ + xoe), (LAS unsigned*)(xl_), 16, 0, 0);             __builtin_amdgcn_global_load_lds((const unsigned*)(xs_ + xoo), (LAS unsigned*)(xl_ + 1024), 16, 0, 0); \
        __builtin_amdgcn_global_load_lds((const unsigned*)(xs_ + x8 + xoe), (LAS unsigned*)(xl_ + 2048), 16, 0, 0); __builtin_amdgcn_global_load_lds((const unsigned*)(xs_ + x8 + xoo), (LAS unsigned*)(xl_ + 3072), 16, 0, 0); \
        __builtin_amdgcn_global_load_lds((const unsigned*)(ws_ + woe), (LAS unsigned*)(wl_), 16, 0, 0);             __builtin_amdgcn_global_load_lds((const unsigned*)(ws_ + woo), (LAS unsigned*)(wl_ + 1024), 16, 0, 0); \
        __builtin_amdgcn_global_load_lds((const unsigned*)(ws_ + w8 + woe), (LAS unsigned*)(wl_ + 2048), 16, 0, 0); __builtin_amdgcn_global_load_lds((const unsigned*)(ws_ + w8 + woo), (LAS unsigned*)(wl_ + 3072), 16, 0, 0); } while (0)
    f32x16 acc0 = f32x16{}, acc1 = f32x16{};
    const int nst = K / 128;
    const int swz = (r32 & 7) << 4;
    SK128_STAGE(0, 0);
    for (int t = 0; t < nst; ++t) {
        VM_WAIT(); __syncthreads();
        if (t + 1 < nst) SK128_STAGE(t + 1, (t + 1) & 1);
        const LAS unsigned char* Xl = lds + (t & 1) * 65536 + wrow * 8192; const LAS unsigned char* Wl = lds + (t & 1) * 65536 + 32768 + wcol * 16384;
#pragma unroll
        for (int d = 0; d < 4; ++d) { const int ka = r32 * 256 + ((d * 32 + hi * 16) ^ swz);
#pragma unroll
            for (int dh = 0; dh < 2; ++dh) {
                const bf16x8 xf = *(const LAS bf16x8*)(Xl + ka + dh * 128);
                const bf16x8 w0 = *(const LAS bf16x8*)(Wl + ka + dh * 128), w1 = *(const LAS bf16x8*)(Wl + 8192 + ka + dh * 128);
                acc0 = __builtin_amdgcn_mfma_f32_32x32x16_bf16(w0, xf, acc0, 0, 0, 0);
                acc1 = __builtin_amdgcn_mfma_f32_32x32x16_bf16(w1, xf, acc1, 0, 0, 0); } }
    }
#undef SK128_STAGE
    E(acc0, n0 + 64 * wcol, 128 * rh + 32 * wrow + r32, r32, hi);
    E(acc1, n0 + 64 * wcol + 32, 128 * rh + 32 * wrow + r32, r32, hi);
    __syncthreads();
}

struct TrItem { const float* src; int ldw; const float* g; bf16_t* dst; int K; };
__device__ __forceinline__ void tr_load(const TrItem& t, f32x2 (&v)[16], int lane) {
    const int kq = lane >> 4, nn = (lane & 15) * 2;
#pragma unroll
    for (int i = 0; i < 16; ++i) v[i] = __builtin_nontemporal_load((const f32x2*)(t.src + (size_t)(4 * i + kq) * t.ldw + nn));
}
__device__ __forceinline__ void tr_process(const TrItem& t, const f32x2 (&v)[16], LAS float* scr, int lane) {
    const int kq = lane >> 4, nn = (lane & 15) * 2;
#pragma unroll
    for (int i = 0; i < 16; ++i) { scr[(4 * i + kq) * 33 + nn] = v[i].x; scr[(4 * i + kq) * 33 + nn + 1] = v[i].y; }
    LDS_WAIT(); asm volatile("" ::: "memory");
    const int c = lane & 7;
    float gv[8];
    if (t.g) { const f32x4 a = *(const f32x4*)(t.g + 8 * c), b = *(const f32x4*)(t.g + 8 * c + 4);
#pragma unroll
        for (int i = 0; i < 4; ++i) { gv[i] = a[i]; gv[4 + i] = b[i]; } }
    else {
#pragma unroll
        for (int i = 0; i < 8; ++i) gv[i] = 1.f; }
#pragma unroll
    for (int j = 0; j < 4; ++j) { const int n = (lane >> 3) + 8 * j; const LAS float* s = scr + (8 * c) * 33 + n;
        u32x4 o; o.x = cvt_pk_bf16(s[0 * 33] * gv[0], s[1 * 33] * gv[1]); o.y = cvt_pk_bf16(s[2 * 33] * gv[2], s[3 * 33] * gv[3]);
        o.z = cvt_pk_bf16(s[4 * 33] * gv[4], s[5 * 33] * gv[5]); o.w = cvt_pk_bf16(s[6 * 33] * gv[6], s[7 * 33] * gv[7]);
        *(u32x4*)(t.dst + (size_t)n * t.K + 8 * c) = o; }
    LDS_WAIT(); asm volatile("" ::: "memory");
}

struct TrCtx { const float *win, *wout, *wgate, *wup, *wdown, *n1g, *n2g; bf16_t *WIN, *WOUT, *WGU, *WDN; };
constexpr int TR_PD1 = 5376;
constexpr int TR_W1PB = 768;
constexpr int TR_IN = 32 * 192, TR_OUT = 32 * 64, TR_G = 32 * 176, TR_D = 88 * 64, TR_L = TR_IN + TR_OUT + 2 * TR_G + TR_D, TR_ALL = 2 * TR_L;
__device__ __forceinline__ void tr_kn(int r, int nblk, int& kb, int& nb) {
    const int B = r >> 3, w = r & 7, nq = nblk >> 2;
    kb = 2 * (B / nq) + (w >> 2); nb = 4 * (B % nq) + (w & 3);
}
__device__ __forceinline__ TrItem tr_decode(const TrCtx& c, int it) {
    const int l = it / TR_L; int r = it % TR_L; TrItem t; int kb, nb;
    if (r < TR_IN) { tr_kn(r, 192, kb, nb); t.src = c.win + ((size_t)l * DM + 64 * kb) * IN_DIM + 32 * nb; t.ldw = IN_DIM; t.g = c.n1g + l * DM + 64 * kb; t.dst = c.WIN + l * WIN_L + (size_t)(32 * nb) * DM + 64 * kb; t.K = DM; return t; }
    r -= TR_IN;
    if (r < TR_OUT) { tr_kn(r, 64, kb, nb); t.src = c.wout + ((size_t)l * DM + 64 * kb) * DM + 32 * nb; t.ldw = DM; t.g = nullptr; t.dst = c.WOUT + l * WOUT_L + (size_t)(32 * nb) * DM + 64 * kb; t.K = DM; return t; }
    r -= TR_OUT;
    if (r < 2 * TR_G) { const int up = r / TR_G; r %= TR_G; tr_kn(r, 176, kb, nb); const int n0 = 32 * nb;
        t.src = (up ? c.wup : c.wgate) + ((size_t)l * DM + 64 * kb) * DFF + n0; t.ldw = DFF; t.g = c.n2g + l * DM + 64 * kb;
        t.dst = c.WGU + l * WGU_L + (size_t)(256 * (n0 / 128) + 128 * up + (n0 % 128)) * DM + 64 * kb; t.K = DM; return t; }
    r -= 2 * TR_G;
    { tr_kn(r, 64, kb, nb); t.src = c.wdown + ((size_t)l * DFF + 64 * kb) * DM + 32 * nb; t.ldw = DM; t.g = nullptr; t.dst = c.WDN + l * WDN_L + (size_t)(32 * nb) * DFF + 64 * kb; t.K = DFF; return t; }
}
template <int N> __device__ __forceinline__ void tr_run(const TrCtx& c, int u0, LAS float* scr, int lane) {
    f32x2 va[16], vb[16];
    TrItem ta = tr_decode(c, u0), tb;
    tr_load(ta, va, lane);
#pragma unroll 1
    for (int uu = 0; uu < N; uu += 2) {
        tb = tr_decode(c, u0 + uu + 1); tr_load(tb, vb, lane);
        tr_process(ta, va, scr, lane);
        if (uu + 2 < N) { ta = tr_decode(c, u0 + uu + 2); tr_load(ta, va, lane); }
        tr_process(tb, vb, scr, lane);
    }
}
template <int NIT> __device__ __forceinline__ void knorm_items(const float* cfk, int it0, float* kpart, int lane) {
    const int half = lane >> 5, c4 = (lane & 31) * 4;
    f32x4 va[12], vb[12];
    float hm[6];
#define KN_LOAD(V, q) do { const int it_ = it0 + ((q) >> 2), pq_ = (q) & 3; const float* b_ = cfk + ((size_t)(it_ / (PAST / 16)) * PAST + (it_ % (PAST / 16)) * 16) * 768; \
        _Pragma("unroll") for (int u_ = 0; u_ < 2; ++u_) _Pragma("unroll") for (int h_ = 0; h_ < 6; ++h_) V[u_ * 6 + h_] = __builtin_nontemporal_load((const f32x4*)(b_ + (size_t)((2 * (2 * pq_ + u_) + half) * 6 + h_) * 128 + c4)); } while (0)
#define KN_REDUCE(V, q) do { if (((q) & 3) == 0) { _Pragma("unroll") for (int h_ = 0; h_ < 6; ++h_) hm[h_] = 0.f; } \
        _Pragma("unroll") for (int u_ = 0; u_ < 2; ++u_) _Pragma("unroll") for (int h_ = 0; h_ < 6; ++h_) { const f32x4 w_ = V[u_ * 6 + h_]; float ss_ = (w_[0] * w_[0] + w_[1] * w_[1]) + (w_[2] * w_[2] + w_[3] * w_[3]); \
            ss_ = swap16_sum(row16_sum(ss_)); hm[h_] = fmaxf(hm[h_], ss_); } \
        if (((q) & 3) == 3) { const int it_ = it0 + ((q) >> 2), lb_ = it_ / (PAST / 16); \
            _Pragma("unroll") for (int h_ = 0; h_ < 6; ++h_) { const float mx_ = swap32_max(hm[h_]); if (lane == 0) kpart[(size_t)(lb_ * NH + h_) * (PAST / 16) + (it_ % (PAST / 16))] = mx_; } } } while (0)
    KN_LOAD(va, 0);
#pragma unroll 1
    for (int q = 0; q < 4 * NIT; q += 2) {
        KN_LOAD(vb, q + 1);
        KN_REDUCE(va, q);
        if (q + 2 < 4 * NIT) KN_LOAD(va, q + 2);
        KN_REDUCE(vb, q + 1);
    }
#undef KN_LOAD
#undef KN_REDUCE
}

#ifndef PB_MASK
#define PB_MASK 31
#endif
#ifndef TIMING
#define TIMING 0
#define TIMING_BX 0
#endif
#define STAMP2(i) do { int t_ = threadIdx.x; asm volatile("" : "+v"(t_)); if (TIMING == 2 && bx == TIMING_BX && t_ == 0) MISC[16 + (i)] = (unsigned)__builtin_amdgcn_s_memrealtime(); } while (0)
#define STAMP3(i) do { int t_ = threadIdx.x; asm volatile("" : "+v"(t_)); if (TIMING == 3 && bx == TIMING_BX && t_ == 0) MISC[16 + (i)] = (unsigned)__builtin_amdgcn_s_memrealtime(); } while (0)
#define STAMP(i) do { int t_ = threadIdx.x; asm volatile("" : "+v"(t_)); if ((TIMING == 1 || TIMING == 3) && bx == TIMING_BX && t_ == 0) MISC[16 + (i)] = (unsigned)__builtin_amdgcn_s_memrealtime(); } while (0)
#ifndef STOP_AFTER
#define STOP_AFTER 99
#endif
struct Params { const float* in[18]; float* out; unsigned char* ws; };
enum { I_XP = 0, I_XS, I_SCONV, I_CSBK, I_CSBV, I_CFK, I_CFV, I_CLOGF, I_N1G, I_WIN, I_BF, I_CONVW, I_WOUT, I_N2G, I_WGATE, I_WUP, I_WDOWN, I_FG };

#define KARG(i) (*(const float* const volatile __attribute__((address_space(4)))*)((const __attribute__((address_space(4))) char*)__builtin_amdgcn_kernarg_segment_ptr() + 8 * (i)))
__global__ void __launch_bounds__(512, 2) hybrid_fwd(Params P) {
    extern __shared__ __attribute__((aligned(16))) unsigned char lds_raw[];
    LAS unsigned char* lds = (LAS unsigned char*)lds_raw;
    volatile LAS unsigned* MISC = (volatile LAS unsigned*)(lds + MISC_OFF);
    const int tid = threadIdx.x, lane = tid & 63; const int wave = __builtin_amdgcn_readfirstlane(tid >> 6);
    const int G = gridDim.x; const int bx = blockIdx.x; const int vcu = (G % 8 == 0) ? (bx % 8) * (G / 8) + bx / 8 : bx;
    const int gw = vcu * 8 + wave, NGW = G * 8;
    unsigned char* ws = P.ws;
    unsigned* ctl = (unsigned*)(ws + WS_CTL);
    float* out = P.out;
    bf16_t* WFB = (bf16_t*)(ws + WS_WF); float* KPART = (float*)(ws + WS_WF + 524288);
    bf16_t* WIN = (bf16_t*)(ws + WS_WIN); bf16_t* WOUT = (bf16_t*)(ws + WS_WOUT); bf16_t* WGU = (bf16_t*)(ws + WS_WGU); bf16_t* WDN = (bf16_t*)(ws + WS_WDN);
    bf16_t* XB = (bf16_t*)(ws + WS_XB); bf16_t* PROJ = (bf16_t*)(ws + WS_PROJ); bf16_t* Y = (bf16_t*)(ws + WS_Y); bf16_t* H = (bf16_t*)(ws + WS_H);
    float* SSQ = (float*)(ctl + CW_SSQ);
    for (int u = tid; u < (LDS_BYTES - RING_BYTES) / 4; u += 512) ((LAS unsigned*)(lds + RING_BYTES))[u] = 0u;
    __syncthreads();
    XcdBarrier bar = xcd_barrier_post(ctl + CW_BAR, MISC + 8);
    STAMP(0); STAMP2(0);

    {
        LAS float* scr = (LAS float*)(lds + wave * 16384);
        constexpr int NITEMS = TR_IN;
        const TrCtx TC{P.in[I_WIN], P.in[I_WOUT], P.in[I_WGATE], P.in[I_WUP], P.in[I_WDOWN], P.in[I_N1G], P.in[I_N2G], WIN, WOUT, WGU, WDN};
        constexpr int N_ROWS = MT, N_KN = DB * (PAST / 16), Q_KN = N_KN / 8, Q_TR = NITEMS / 32, Q_ROW = N_ROWS / 32, Q_ALL = Q_KN + Q_TR + Q_ROW;
        volatile LAS unsigned* qidx0 = MISC + 12;
        for (;;) {
            if (tid == 0) qidx0[0] = __hip_atomic_fetch_add(ctl + CW_Q + 128, 1u, __ATOMIC_RELAXED, __HIP_MEMORY_SCOPE_AGENT);
            __syncthreads();
            const int qi = (int)qidx0[0];
            __syncthreads();
            if (qi >= Q_ALL) break;
            if (qi < Q_KN) { knorm_items<1>(P.in[I_CFK], qi * 8 + wave, KPART, lane); continue; }
            if (qi < Q_KN + Q_TR) { tr_run<4>(TC, ((qi - Q_KN) * 8 + wave) * 4, scr, lane); continue; }
            {
                const int r0 = ((qi - Q_KN - Q_TR) * 8 + wave) * 4;
                f32x4 xa[8], xb[8];
#define ROW_PTR(r) (((r) < SEQ) ? P.in[I_XP] + (size_t)(r) * DM : P.in[I_XS] + (size_t)((r) - SEQ) * DM)
#define ROW_LOAD(V, r) do { const float* xr_ = ROW_PTR(r); _Pragma("unroll") for (int i_ = 0; i_ < 4; ++i_) { V[2 * i_] = __builtin_nontemporal_load((const f32x4*)(xr_ + 8 * lane + 512 * i_)); V[2 * i_ + 1] = __builtin_nontemporal_load((const f32x4*)(xr_ + 8 * lane + 512 * i_ + 4)); } } while (0)
#define ROW_DONE(V, r) do { float s_ = 0.f; _Pragma("unroll") for (int i_ = 0; i_ < 4; ++i_) { const f32x4 a_ = V[2 * i_], b_ = V[2 * i_ + 1]; \
        s_ += (a_[0] * a_[0] + a_[1] * a_[1]) + (a_[2] * a_[2] + a_[3] * a_[3]) + (b_[0] * b_[0] + b_[1] * b_[1]) + (b_[2] * b_[2] + b_[3] * b_[3]); \
        u32x4 w_; w_.x = cvt_pk_bf16(a_[0], a_[1]); w_.y = cvt_pk_bf16(a_[2], a_[3]); w_.z = cvt_pk_bf16(b_[0], b_[1]); w_.w = cvt_pk_bf16(b_[2], b_[3]); \
        *(u32x4*)(XB + (size_t)(r) * DM + 8 * lane + 512 * i_) = w_; } \
        s_ = wave_sum(s_); if (lane == 0) SSQ[(r)] = s_; } while (0)
                ROW_LOAD(xa, r0);
#pragma unroll 1
                for (int uu = 0; uu < 4; uu += 2) {
                    ROW_LOAD(xb, r0 + uu + 1);
                    ROW_DONE(xa, r0 + uu);
                    if (uu + 2 < 4) ROW_LOAD(xa, r0 + uu + 2);
                    ROW_DONE(xb, r0 + uu + 1);
                }
#undef ROW_PTR
#undef ROW_LOAD
#undef ROW_DONE
            }
        }
        STAMP2(2);
        for (int e = vcu * 512 + tid; e < 2 * 32 * DM; e += G * 512) {
            const int l = e / (32 * DM), j = (e % (32 * DM)) / DM, k = e % DM;
            const float v = (j < NH) ? P.in[I_N1G][l * DM + k] * P.in[I_WIN][((size_t)l * DM + k) * IN_DIM + NPROJ + j] : 0.f;
            WFB[e] = (bf16_t)(cvt_pk_bf16(v, 0.f) & 0xffffu);
        }
        STAMP2(3);
    }
    STAMP2(4);
    xcd_barrier(bar);
    STAMP(1); STAMP2(5);

    for (int l = 0; l < 2; ++l) {
        int tid = threadIdx.x; asm volatile("" : "+v"(tid)); const int lane = tid & 63; const int gw = vcu * 8 + __builtin_amdgcn_readfirstlane(tid >> 6);
        long zoff = 0; asm volatile("" : "+s"(zoff));
        unsigned char* ws = P.ws + zoff; float* out = P.out + zoff;
        unsigned* ctl = (unsigned*)(ws + WS_CTL);
        bf16_t* WFB = (bf16_t*)(ws + WS_WF); float* KPART = (float*)(ws + WS_WF + 524288);
        bf16_t* WIN = (bf16_t*)(ws + WS_WIN); bf16_t* WOUT = (bf16_t*)(ws + WS_WOUT); bf16_t* WGU = (bf16_t*)(ws + WS_WGU); bf16_t* WDN = (bf16_t*)(ws + WS_WDN);
        bf16_t* XB = (bf16_t*)(ws + WS_XB); bf16_t* PROJ = (bf16_t*)(ws + WS_PROJ); bf16_t* Y = (bf16_t*)(ws + WS_Y); bf16_t* H = (bf16_t*)(ws + WS_H);
        float* SSQ = (float*)(ctl + CW_SSQ);
        const float* ssq_in = SSQ + (size_t)(2 * l) * MT;
        float* ssq_mid = SSQ + (size_t)(2 * l + 1) * MT;
        float* ssq_next = SSQ + (size_t)(2 * l + 2) * MT;
        {
            if (l == 0) STAMP2(6);
            const SkProj SE{PROJ, ssq_in, out, l, ctl + CW_KMAXS};
            constexpr int NSK = 2 * (NPROJ / 128), NLG = 4 * (MT / 256);
            int si0, si1, sis, lq0, lq1, lqs;
            if (G == 256) { const int x = (bx & 7) >> 1, i = bx >> 3, hr = (bx >> 3) * 4 + ((bx & 7) >> 1);
                const bool lightw = !(bx & 1);
                si0 = (lightw && i < 24) ? x * 24 + i : NSK; si1 = NSK; sis = 1 << 20;
                lq0 = lightw ? (i >= 24 ? 128 + x * 8 + (i - 24) : NLG) : hr; lq1 = NLG; lqs = 1 << 20;
            } else { si0 = bx; si1 = NSK; sis = G; lq0 = bx; lq1 = NLG; lqs = G; }
            for (int i = si0; i < si1; i += sis) skinny128_item(lds, XB + (size_t)SEQ * DM, DM, WIN + l * WIN_L, DM, DM, 128 * (i >> 1), i & 1, SE);
            const bool lg_first = (G == 256) && ((bx >> 3) & 1);
            if (lg_first) for (int q = lq0; q < lq1; q += lqs) {
                const SkLogit LE{ssq_in, KARG(I_BF) + l * NH, out, l, 256 * (q >> 2)};
                skinny_item<4>(lds, XB + (size_t)(q >> 2) * 256 * DM, DM, WFB + (size_t)l * 32 * DM, DM, DM, 0, q & 3, LE);
            }
            if (l == 0) STAMP2(7);
            pg8::Gemm g{XB, WIN + l * WIN_L, SEQ, NPROJ, DM}; pg8::StaticOrder S; S.init(SEQ, NPROJ, G, bx, 1);
            pg8::EpiProj E{PROJ, ssq_in, out, l, ctl + CW_KMAXP};
            pg8::gemm_phase<pg8::EpiProj, pg8::StaticOrder, true, true>(lds, g, S, E);
            if (l == 0) STAMP(2);
            if (!lg_first) for (int q = lq0; q < lq1; q += lqs) {
                const SkLogit LE{ssq_in, KARG(I_BF) + l * NH, out, l, 256 * (q >> 2)};
                skinny_item<4>(lds, XB + (size_t)(q >> 2) * 256 * DM, DM, WFB + (size_t)l * 32 * DM, DM, DM, 0, q & 3, LE);
            }
        }
        if (l == 0) STAMP2(8);
        xcd_barrier(bar);
        STAMP(l == 0 ? 3 : 10); if (l == 0) STAMP2(9);
        if (STOP_AFTER == 1 + 5 * l) return;
        {
            constexpr int NHP = NH / 2, N_PA = 2 * 64 * NHP, N_SA = 2 * DB * NHP, N_CV = MT / 64, N_ALL = N_PA + N_SA + N_CV;
            const int n_a = N_ALL + (l == 0 ? DB * (PAST / 16) / 8 : 0);
            const bool win1_in_pd = (G == 256);
            const int cv_first = (l == 0) ? TR_IN : TR_L + TR_IN, n_b = ((l == 0) ? (win1_in_pd ? TR_L - TR_IN + TR_W1PB : TR_L) : TR_L - TR_IN - (win1_in_pd ? TR_PD1 : 0)) / 32;
            const int n_min = n_a < n_b ? n_a : n_b, n_items = n_a + n_b;
            const TrCtx TC{KARG(I_WIN), KARG(I_WOUT), KARG(I_WGATE), KARG(I_WUP), KARG(I_WDOWN), KARG(I_N1G), KARG(I_N2G), WIN, WOUT, WGU, WDN};
            volatile LAS unsigned* qidx = MISC + 12;
            for (;;) {
                if (tid == 0) qidx[0] = __hip_atomic_fetch_add(ctl + CW_Q + 64 * l, 1u, __ATOMIC_RELAXED, __HIP_MEMORY_SCOPE_AGENT);
                __syncthreads();
                const int qi = (int)qidx[0];
                __syncthreads();
                if (qi >= n_items) break;
                int idx, cvi = -1;
                if (qi < 2 * n_min) { if (qi & 1) cvi = qi >> 1; idx = qi >> 1; } else if (n_a > n_b) idx = qi - n_min; else { cvi = qi - n_min; idx = 0; }
                if (cvi >= 0) { tr_run<4>(TC, cv_first + (cvi * 8 + __builtin_amdgcn_readfirstlane(tid >> 6)) * 4, (LAS float*)(lds + __builtin_amdgcn_readfirstlane(tid >> 6) * 16384), lane); continue; }
                {
                    const int n_kn = n_a - N_ALL, ia = idx - (N_PA + N_SA);
                    if (ia >= 0 && ia < n_kn) { knorm_items<1>(KARG(I_CFK), DB * (PAST / 16) + ia * 8 + __builtin_amdgcn_readfirstlane(tid >> 6), KPART, lane); continue; }
                    if (ia >= n_kn) idx -= n_kn;
                }
                if (idx < N_PA + N_SA) {
                    AttnItem it;
                    int type, h, b = 0;
                    if (idx >= N_SA) { const int ip = idx - N_SA; type = ip / (64 * NHP); const int rem = ip % (64 * NHP); const int qt = 63 - rem / NHP; h = 2 * (rem % NHP);
                        it.nq = 128; it.t0 = 128 * qt; it.Kc = 0; it.Knew_cnt = SEQ;
                        it.Q = PROJ + (size_t)it.t0 * NPROJ; it.Knew = PROJ; it.Vnew = PROJ; it.Kcache = nullptr; it.Vcache = nullptr; it.Lcache = nullptr;
                        it.Lnew = out + O_PLOGF + (size_t)l * SEQ * 6 + h; it.O = Y + (size_t)it.t0 * DM;
                        const unsigned* km = ctl + CW_KMAXP + (l * NH + h) * 4;
                        it.kn2 = (__uint_as_float(km[0]) + __uint_as_float(km[1])) + (__uint_as_float(km[2]) + __uint_as_float(km[3]));
                        it.kn2b = (__uint_as_float(km[4]) + __uint_as_float(km[5])) + (__uint_as_float(km[6]) + __uint_as_float(km[7]));
                    } else { const int k = idx; type = k / (DB * NHP); b = (k % (DB * NHP)) / NHP; h = 2 * (k % NHP);
                        it.nq = DSEQ; it.t0 = PAST; it.Kc = PAST; it.Knew_cnt = DSEQ;
                        const size_t row0 = (size_t)SEQ + DSEQ * b;
                        it.Q = PROJ + row0 * NPROJ; it.Knew = PROJ + row0 * NPROJ; it.Vnew = PROJ + row0 * NPROJ;
                        const size_t coff = ((size_t)(l * DB + b) * PAST) * 768 + h * HD;
                        it.Kcache = P.in[type == 0 ? I_CSBK : I_CFK] + coff; it.Vcache = P.in[type == 0 ? I_CSBV : I_CFV] + coff;
                        it.Lcache = KARG(I_CLOGF) + ((size_t)(l * DB + b) * PAST) * 6 + h;
                        it.Lnew = out + O_SLOGF + ((size_t)l * NSMP + DSEQ * b) * 6 + h; it.O = Y + row0 * DM;
                        const unsigned* km = ctl + CW_KMAXS + ((l * DB + b) * NH + h) * 4;
                        const float kn_new = (__uint_as_float(km[0]) + __uint_as_float(km[1])) + (__uint_as_float(km[2]) + __uint_as_float(km[3]));
                        const float kn_newb = (__uint_as_float(km[4]) + __uint_as_float(km[5])) + (__uint_as_float(km[6]) + __uint_as_float(km[7]));
                        float kc = KPART[(size_t)((l * DB + b) * NH + h + (tid >> 8)) * (PAST / 16) + (tid & 255)];
                        kc = swap32_max(fmaxf(row16_max(kc), 0.f)); { auto rr = __builtin_amdgcn_permlane16_swap(__float_as_uint(kc), __float_as_uint(kc), false, false); kc = fmaxf(__uint_as_float(rr[0]), __uint_as_float(rr[1])); }
                        volatile LAS float* kred = (volatile LAS float*)(lds + AL_FLAG + 128);
                        if (lane == 0) kred[tid >> 6] = kc;
                        __syncthreads();
                        it.kn2 = fmaxf(kn_new, fmaxf(fmaxf(kred[0], kred[1]), fmaxf(kred[2], kred[3])));
                        it.kn2b = fmaxf(kn_newb, fmaxf(fmaxf(kred[4], kred[5]), fmaxf(kred[6], kred[7])));
                    }
                    it.sb = (type == 0);
                    const int cq_ = (type == 0 ? C_SQ : C_FQ) + h * HD, ck_ = (type == 0 ? C_SK : C_FK) + h * HD, cv_ = (type == 0 ? C_SV : C_FV) + h * HD;
                    it.Q += cq_; it.Knew += ck_; it.Vnew += cv_; it.O += (type == 0 ? CONVD : CONVD + NH * HD) + h * HD;
                    const int pbit = (idx >= N_SA ? 1 : 4) << (type == 0 ? 0 : 1);
                    if (PB_MASK & pbit) { if (type == 0) attn_item<1>(it, lds); else attn_item<0>(it, lds); }
                } else {
                    if (PB_MASK & 16) conv_item(idx - (N_PA + N_SA), l, PROJ, Y, KARG(I_SCONV), KARG(I_CONVW), out);
                }
            }
        }
        xcd_barrier(bar);
        STAMP(l == 0 ? 4 : 11); if (l == 0) STAMP2(10);
        if (STOP_AFTER == 2 + 5 * l) {
            for (size_t e = (size_t)bx * 512 + tid; e < (size_t)SEQ * DM; e += (size_t)G * 512) out[O_YP + e] = bf_lo((unsigned)Y[e]);
            return; }
        {
            pg8::Gemm g{Y, WOUT + l * WOUT_L, SEQ, DM, DM}; pg8::StaticOrder S; S.init(SEQ, DM, G, bx);
            const int nsk = 4 * (DM / 32);
            const bool sk_first = (G == 256) && ((bx >> 3) & 1);
            {
                pg8::EpiRes<false> E{nullptr, XB, ssq_mid};
                const SkRes<false> SE{nullptr, XB, ssq_mid};
#pragma unroll 1
                for (int step = 0; step < 2; ++step) {
                    if ((step == 0) == sk_first) { for (int i = bx; i < nsk; i += G) skinny_item<4>(lds, Y + (size_t)SEQ * DM, DM, WOUT + l * WOUT_L, DM, DM, 32 * (i >> 2), i & 3, SE); }
                    else { pg8::gemm_phase<pg8::EpiRes<false>, pg8::StaticOrder, true, true>(lds, g, S, E); if (l == 0) { STAMP(5); STAMP2(11); } }
                }
            }
        }
        if (l == 0) STAMP2(12);
        xcd_barrier(bar);
        STAMP(l == 0 ? 6 : 12); if (l == 0) STAMP2(13);
        if (STOP_AFTER == 3 + 5 * l) {
            for (size_t e = (size_t)bx * 512 + tid; e < (size_t)SEQ * DM; e += (size_t)G * 512) out[O_YP + e] = bf_lo((unsigned)XB[e]);
            return; }
        {
            pg8::Gemm g{XB, WGU + l * WGU_L, MT, NGU, DM}; pg8::StaticOrder S; S.init(MT, NGU, G, bx);
            pg8::EpiGU E{H, ssq_mid};
            pg8::gemm_phase<pg8::EpiGU, pg8::StaticOrder, true, true>(lds, g, S, E);
            constexpr int N_PD = (MT / 256) * (NGU / 256), N_LAST = N_PD % 256;
            if (l == 1 && G == 256 && bx >= N_LAST) {
                const TrCtx TC{KARG(I_WIN), KARG(I_WOUT), KARG(I_WGATE), KARG(I_WUP), KARG(I_WDOWN), KARG(I_N1G), KARG(I_N2G), WIN, WOUT, WGU, WDN};
                int tc = threadIdx.x; asm volatile("" : "+v"(tc));
                const int lane = tc & 63; const int wv = __builtin_amdgcn_readfirstlane(tc >> 6);
                for (int u = 2 * TR_L - TR_PD1 + ((bx - N_LAST) * 8 + wv) * 4; u < 2 * TR_L; u += (256 - N_LAST) * 8 * 4) tr_run<4>(TC, u, (LAS float*)(lds + wv * 16384), lane);
            }
            if (l == 0 && G == 256 && bx >= N_LAST) {
                const TrCtx TC{KARG(I_WIN), KARG(I_WOUT), KARG(I_WGATE), KARG(I_WUP), KARG(I_WDOWN), KARG(I_N1G), KARG(I_N2G), WIN, WOUT, WGU, WDN};
                const int wv = __builtin_amdgcn_readfirstlane(tid >> 6);
                for (int u = TR_L + TR_W1PB + ((bx - N_LAST) * 8 + wv) * 4; u < TR_L + TR_IN; u += (256 - N_LAST) * 8 * 4) tr_run<4>(TC, u, (LAS float*)(lds + wv * 16384), lane);
            }
        }
        xcd_barrier(bar);
        if (TIMING == 3) { if (l == 0) STAMP3(7); } else STAMP(l == 0 ? 7 : 13); if (l == 0) STAMP2(14);
        if (STOP_AFTER == 4 + 5 * l) {
            for (size_t e = (size_t)bx * 512 + tid; e < (size_t)SEQ * DM; e += (size_t)G * 512) out[O_YP + e] = bf_lo((unsigned)H[(e / DM) * DFF + (e % DM)]);
            return; }
        {
            pg8::Gemm g{H, WDN + l * WDN_L, SEQ, DM, DFF}; pg8::StaticOrder S; S.init(SEQ, DM, G, bx);
            pg8::EpiRes<false> E{nullptr, XB, ssq_next};
            const SkRes<false> SE{nullptr, XB, ssq_next};
            const bool sk_first = (G == 256) && ((bx >> 3) & 1);
#pragma unroll 1
            for (int step = 0; step < 2; ++step) {
                if ((step == 0) == sk_first) { for (int i = bx; i < 4 * (DM / 32); i += G) skinny_item<4>(lds, H + (size_t)SEQ * DFF, DFF, WDN + l * WDN_L, DFF, DFF, 32 * (i >> 2), i & 3, SE); }
                else { pg8::gemm_phase<pg8::EpiRes<false>, pg8::StaticOrder, true, true>(lds, g, S, E); if (l == 0) STAMP(8); }
            }
        }
        xcd_barrier(bar);
        if (TIMING == 3) STAMP3(l == 0 ? 9 : 13); else STAMP(l == 0 ? 9 : 14);
        if (STOP_AFTER == 5 + 5 * l) {
            for (size_t e = (size_t)bx * 512 + tid; e < (size_t)SEQ * DM; e += (size_t)G * 512) out[O_YP + e] = bf_lo((unsigned)XB[e]);
            return; }
    }
    {
        int tid_f = threadIdx.x; asm volatile("" : "+v"(tid_f));
        const int lane = tid_f & 63; const int gw = vcu * 8 + __builtin_amdgcn_readfirstlane(tid_f >> 6);
        const float* ssq_f = SSQ + (size_t)4 * MT; const float* fg = KARG(I_FG);
        const unsigned tmo = __hip_atomic_load(ctl + CW_BAR + XB_TMO, __ATOMIC_RELAXED, __HIP_MEMORY_SCOPE_AGENT);
        const int n_main = SEQ / NGW + ((gw < SEQ % NGW) ? 1 : 0), n_all = n_main + ((__builtin_amdgcn_readfirstlane(tid_f >> 6) == 0) ? (NSMP - vcu + G - 1) / G : 0);
        for (int q = 0; q < n_all; ++q) {
            const int r = (q < n_main) ? gw + q * NGW : SEQ + vcu + (q - n_main) * G;
            float rs = rsqrtf(ssq_f[r] * (1.0f / DM) + EPS);
            if (tmo) rs = __builtin_nanf("");
            const bf16_t* xr = XB + (size_t)r * DM; float* yo = (r < SEQ) ? out + O_YP + (size_t)r * DM : out + O_YS + (size_t)(r - SEQ) * DM;
#pragma unroll
            for (int i = 0; i < 8; ++i) { const u32x2 w = *(const u32x2*)(xr + 4 * lane + 256 * i); const f32x4 x = {bf_lo(w.x), bf_hi(w.x), bf_lo(w.y), bf_hi(w.y)}, gq = *(const f32x4*)(fg + 4 * lane + 256 * i);
                __builtin_nontemporal_store(x * rs * gq, (f32x4*)(yo + 4 * lane + 256 * i)); }
        }
    }
    if (TIMING) {
        STAMP(15); STAMP3(14);
        xcd_barrier(bar);
        if (bx == TIMING_BX) {
            const size_t offs[15] = {O_YP, O_YS, O_PCONV, O_PSBK, O_PSBV, O_PFK, O_PFV, O_PLOGF, O_SCONV, O_SSBK, O_SSBV, O_SFK, O_SFV, O_SLOGF, O_TOTAL};
#pragma unroll 1
            for (int k = 0; k < 14; ++k) {
                unsigned n = MISC[16 + k + 1] - MISC[16 + k]; n = (n + 5u) / 10u;
                size_t cap = offs[k + 1] - offs[k]; if (cap > 60000) cap = 60000; if (n > cap) n = (unsigned)cap;
                for (unsigned e = tid; e < (unsigned)cap; e += 512) ((unsigned*)out)[offs[k] + e] = (e < n) ? 0xAAAAAAAAu : 0u;
            }
        }
    }
}

extern "C" void kernel_launch(void* const* d_in, const int* in_sizes, int n_in, void* d_out, int out_size, void* d_ws, size_t ws_size, hipStream_t stream) {
    static int grid = 0;
    if (grid == 0) {
        if (n_in != 18 || (size_t)out_size != O_TOTAL || ws_size < WS_END) { fprintf(stderr, "kernel_launch: unexpected shapes (n_in %d out %d ws %zu)\n", n_in, out_size, ws_size); grid = -1; return; }
        int dev = 0, cus = 0, per_cu = 0;
        if (hipGetDevice(&dev) != hipSuccess || hipDeviceGetAttribute(&cus, hipDeviceAttributeMultiprocessorCount, dev) != hipSuccess) { grid = -1; return; }
        if (hipFuncSetAttribute((const void*)hybrid_fwd, hipFuncAttributeMaxDynamicSharedMemorySize, LDS_BYTES) != hipSuccess) { fprintf(stderr, "kernel_launch: hipFuncSetAttribute failed\n"); grid = -1; return; }
        if (hipOccupancyMaxActiveBlocksPerMultiprocessor(&per_cu, (const void*)hybrid_fwd, 512, LDS_BYTES) != hipSuccess || per_cu < 1) { fprintf(stderr, "kernel_launch: occupancy query says %d\n", per_cu); }
        (void)hipGetLastError();
        grid = cus;
    }
    if (grid < 0) return;
    if (hipMemsetAsync((char*)d_ws + WS_CTL, 0, CTL_ZERO_BYTES, stream) != hipSuccess) return;
    Params p{};
    for (int i = 0; i < 18; ++i) p.in[i] = (const float*)d_in[i];
    p.out = (float*)d_out; p.ws = (unsigned char*)d_ws;
    hipLaunchKernelGGL(hybrid_fwd, dim3(grid), dim3(512), LDS_BYTES, stream, p);
}
```

```cpp
#include <hip/hip_runtime.h>
#include <cstdio>
#include <cstdint>
#include <cmath>

#define LAS __attribute__((address_space(3)))
#define GAS __attribute__((address_space(1)))
typedef unsigned short bf16_t;
typedef short bf16x8 __attribute__((ext_vector_type(8)));
typedef short s16x4 __attribute__((ext_vector_type(4)));
typedef float f32x2 __attribute__((ext_vector_type(2)));
typedef float f32x4 __attribute__((ext_vector_type(4)));
typedef float f32x16 __attribute__((ext_vector_type(16)));
typedef unsigned u32x2 __attribute__((ext_vector_type(2)));
typedef unsigned u32x4 __attribute__((ext_vector_type(4)));
typedef GAS unsigned gu32;

constexpr int DM = 2048, SEQ = 8192, NSMP = 256, MT = SEQ + NSMP  ;
constexpr int NPROJ = 6144, IN_DIM = 6150, DFF = 5632, NGU = 2 * DFF, PAST = 4096, DSEQ = 32, DB = 8, NH = 6, HD = 128, CONVD = 512;
constexpr int C_GB = 0, C_GC = 512, C_HC = 1024, C_SQ = 1536, C_SK = 2304, C_SV = 3072, C_FQ = 3840, C_FK = 4608, C_FV = 5376;
constexpr float EPS = 1e-5f, LOG2E = 1.4426950408889634f, LN2 = 0.6931471805599453f, QK_SCALE = 0.08838834764831845f;
constexpr float EXIT_T = 40.f;
constexpr size_t O_YP = 0, O_YS = 16777216, O_PCONV = 17301504, O_PSBK = 17303552, O_PSBV = 29886464, O_PFK = 42469376, O_PFV = 55052288, O_PLOGF = 67635200,
                 O_SCONV = 67733504, O_SSBK = 67749888, O_SSBV = 68143104, O_SFK = 68536320, O_SFV = 68929536, O_SLOGF = 69322752, O_TOTAL = 69325824;
constexpr size_t P_KV_STRIDE = (size_t)2 * SEQ * 768, S_KV_STRIDE = (size_t)2 * NSMP * 768;
constexpr size_t MiB = 1u << 20;
constexpr size_t WS_CTL = 0, CTL_ZERO_BYTES = 256 * 1024  , WS_WF = 1 * MiB, WS_WIN = 2 * MiB, WS_WOUT = 50 * MiB, WS_WGU = 66 * MiB, WS_WDN = 154 * MiB,
                 WS_XB = 198 * MiB, WS_XF = 231 * MiB, WS_PROJ = 297 * MiB, WS_Y = 396 * MiB, WS_H = 429 * MiB, WS_END = 520 * MiB;
constexpr size_t WIN_L = (size_t)NPROJ * DM, WOUT_L = (size_t)DM * DM, WGU_L = (size_t)NGU * DM, WDN_L = (size_t)DM * DFF;
constexpr int CW_BAR = 4096, CW_Q = 8192, CW_KMAXP = 8192 + 256, CW_KMAXS = 8192 + 512, CW_KMAXC = 8192 + 1024, CW_SSQ = 16384;
constexpr int RING_BYTES = 131072, MISC_OFF = RING_BYTES + 320, LDS_BYTES = 147456;

typedef __bf16 bf16x2_t __attribute__((ext_vector_type(2)));
__device__ __forceinline__ unsigned cvt_pk_bf16(float lo, float hi) { const f32x2 v = {lo, hi}; const bf16x2_t b = __builtin_convertvector(v, bf16x2_t); return __builtin_bit_cast(unsigned, b); }
__device__ __forceinline__ float bf_lo(unsigned w) { return __uint_as_float(w << 16); }
__device__ __forceinline__ float bf_hi(unsigned w) { return __uint_as_float(w & 0xffff0000u); }
template <int CTRL> __device__ __forceinline__ float dpp_mov(float v) { return __int_as_float(__builtin_amdgcn_update_dpp(0, __float_as_int(v), CTRL, 0xF, 0xF, true)); }
__device__ __forceinline__ float row16_sum(float v) { v += dpp_mov<0xB1>(v); v += dpp_mov<0x4E>(v); v += dpp_mov<0x141>(v); v += dpp_mov<0x140>(v); return v; }
__device__ __forceinline__ float row16_max(float v) { v = fmaxf(v, dpp_mov<0xB1>(v)); v = fmaxf(v, dpp_mov<0x4E>(v)); v = fmaxf(v, dpp_mov<0x141>(v)); v = fmaxf(v, dpp_mov<0x140>(v)); return v; }
__device__ __forceinline__ float swap16_sum(float v) { auto rr = __builtin_amdgcn_permlane16_swap(__float_as_uint(v), __float_as_uint(v), false, false); return __uint_as_float(rr[0]) + __uint_as_float(rr[1]); }
__device__ __forceinline__ float swap32_sum(float v) { auto rr = __builtin_amdgcn_permlane32_swap(__float_as_uint(v), __float_as_uint(v), false, false); return __uint_as_float(rr[0]) + __uint_as_float(rr[1]); }
__device__ __forceinline__ float swap32_max(float v) { auto rr = __builtin_amdgcn_permlane32_swap(__float_as_uint(v), __float_as_uint(v), false, false); return fmaxf(__uint_as_float(rr[0]), __uint_as_float(rr[1])); }
__device__ __forceinline__ float wave_sum(float v) { return swap32_sum(swap16_sum(row16_sum(v))); }
__device__ __forceinline__ float bperm(int src_lane, float v) { return __int_as_float(__builtin_amdgcn_ds_bpermute(src_lane << 2, __float_as_int(v))); }
__device__ __forceinline__ float ex2(float x) { return __builtin_amdgcn_exp2f(x); }
__device__ __forceinline__ float lg2(float x) { return __builtin_amdgcn_logf(x); }
__device__ __forceinline__ float partner32(float v, int hi) {
    auto rr = __builtin_amdgcn_permlane32_swap(__float_as_uint(v), __float_as_uint(v), false, false);
    return __uint_as_float(hi ? rr[0] : rr[1]);
}
__device__ __forceinline__ void st16_wt(void* p, u32x4 v) { asm volatile("global_store_dwordx4 %0, %1, off sc1\n\ts_nop 1" :: "v"(p), "v"(v)); }
#define LDS_WAIT() asm volatile("s_waitcnt lgkmcnt(0)" ::: "memory")
#define VM_WAIT() asm volatile("s_waitcnt vmcnt(0)" ::: "memory")

namespace pg8 {
constexpr int BM = 256, BK = 64, HALF = 128, HTB = HALF * BK * 2, STAGE_BYTES = 8 * HTB, NXCD = 8, WGM = 8;
__host__ __device__ __forceinline__ int lds_byte(int r, int c) { const int st = (r >> 4) * 2 + (c >> 5), rr = r & 15, cc = c & 31, ob = rr * 64 + cc * 2; return st * 1024 + (ob ^ (((ob >> 9) & 1) << 5)); }
__host__ __device__ __forceinline__ void stage_rc(int b, int& R, int& C) { const int st = b / 1024, sb = b % 1024, swz = sb ^ (((sb >> 9) & 1) << 5); R = (st >> 1) * 16 + swz / 64; C = (st & 1) * 32 + (swz % 64) / 2; }
__host__ __device__ __forceinline__ int perm32(int rho) { const int n = rho >> 4, i = rho & 15; return 8 * (i >> 2) + 4 * n + (i & 3); }
struct Unit { int pm, pn; };
struct Gemm { const bf16_t* A; const bf16_t* Bt; int M, N, K; };
struct StaticOrder {
    int nM, nN, nwg, G, c, perm24;
    __host__ __device__ void init(int M, int N, int G_, int c_, int perm24_ = 0) { nM = M / BM; nN = N / BM; nwg = nM * nN; G = G_; c = c_; perm24 = perm24_; }
    __host__ __device__ bool next(int i, Unit& u) const {
        const long L = (long)i * G + c; if (L >= nwg) return false;
        int wgid = (int)L; { const int q = nwg / NXCD, r = nwg % NXCD, xcd = wgid % NXCD, off = wgid / NXCD; wgid = (xcd < r ? xcd * (q + 1) : r * (q + 1) + (xcd - r) * q) + off; }
        const int nig = WGM * nN, gid = wgid / nig, fm = gid * WGM, gsz = (nM - fm) < WGM ? (nM - fm) : WGM;
        u.pm = fm + ((wgid % nig) % gsz); u.pn = (wgid % nig) / gsz;
        if (perm24) {
            const unsigned long long LO = 0ull | (0ull << 0) | (1ull << 5) | (2ull << 10) | (3ull << 15) | (9ull << 20) | (10ull << 25) | (11ull << 30) | (12ull << 35) | (4ull << 40) | (5ull << 45) | (6ull << 50) | (7ull << 55);
            const unsigned long long HI = 0ull | (13ull << 0) | (14ull << 5) | (18ull << 10) | (19ull << 15) | (8ull << 20) | (15ull << 25) | (16ull << 30) | (17ull << 35) | (20ull << 40) | (21ull << 45) | (22ull << 50) | (23ull << 55);
            u.pn = (int)(((u.pn < 12) ? (LO >> (5 * u.pn)) : (HI >> (5 * (u.pn - 12)))) & 31ull);
        }
        return true;
    }
    __device__ __forceinline__ void a_ready(const Unit&) const {}
    __device__ __forceinline__ void done(const Unit&) const {}
};


struct EpiProj {
    static constexpr bool PERM = true, AFTER_DRAIN = false;
    bf16_t* proj; const float* ssq; float* out; int layer; unsigned* kmaxp;
    __device__ __forceinline__ void operator()(const f32x4 (&acc)[2][2][4][2], const Unit& u, int wr, int wc, int fr, int fq) const {
        const int row0 = u.pm * BM + wr * 64 + fr, col0 = u.pn * BM + wc * 32 + 8 * fq;
        int seg = -1, segcol = 0;
        if (u.pn >= 9 && u.pn < 15) { seg = (u.pn - 9) / 3; segcol = ((u.pn - 9) % 3) * 256; }
        else if (u.pn >= 18) { seg = 2 + (u.pn - 18) / 3; segcol = ((u.pn - 18) % 3) * 256; }
        const bool isfk = (u.pn >= 18 && u.pn < 21);
        float ssr[2][2][4];
#pragma unroll
        for (int ai = 0; ai < 2; ++ai)
#pragma unroll
            for (int m = 0; m < 4; ++m) {
                const int r = row0 + ai * HALF + m * 16;
                const float rs = rsqrtf(ssq[r] * (1.0f / DM) + EPS);
                bf16_t* rowp = proj + (size_t)r * NPROJ + col0;
                float* orow = nullptr; const int odd = fr & 1;
                if (seg >= 0) orow = out + O_PSBK + (size_t)seg * P_KV_STRIDE + ((size_t)layer * SEQ + (r - odd)) * 768 + segcol + wc * 32 + 8 * fq + 4 * odd;
#pragma unroll
                for (int bj = 0; bj < 2; ++bj) {
                    const f32x4 v0 = acc[ai][bj][m][0] * rs, v1 = acc[ai][bj][m][1] * rs;
                    u32x4 w; w.x = cvt_pk_bf16(v0[0], v0[1]); w.y = cvt_pk_bf16(v0[2], v0[3]); w.z = cvt_pk_bf16(v1[0], v1[1]); w.w = cvt_pk_bf16(v1[2], v1[3]);
                    *(u32x4*)(rowp + bj * HALF) = w;
                    if (seg >= 0) {
                        const f32x4 x = odd ? v0 : v1;
                        const f32x4 rc = {dpp_mov<0xB1>(x[0]), dpp_mov<0xB1>(x[1]), dpp_mov<0xB1>(x[2]), dpp_mov<0xB1>(x[3])};
                        __builtin_nontemporal_store(odd ? rc : v0, (f32x4*)(orow + bj * HALF)); __builtin_nontemporal_store(odd ? v1 : rc, (f32x4*)(orow + bj * HALF + 768)); }
                    float ss = (v0[0] * v0[0] + v0[1] * v0[1]) + (v0[2] * v0[2] + v0[3] * v0[3]) + (v1[0] * v1[0] + v1[1] * v1[1]) + (v1[2] * v1[2] + v1[3] * v1[3]);
                    ssr[bj][ai][m] = ss;
                }
            }
        if (isfk) {
#pragma unroll
            for (int bj = 0; bj < 2; ++bj) {
                const int head = 2 * (u.pn - 18) + bj;
                float pr[2][4];
#pragma unroll
                for (int ai = 0; ai < 2; ++ai)
#pragma unroll
                    for (int m = 0; m < 4; ++m) pr[ai][m] = swap32_sum(swap16_sum(ssr[bj][ai][m]));
                {
                    float mx = fmaxf(fmaxf(fmaxf(pr[0][0], pr[0][1]), fmaxf(pr[0][2], pr[0][3])), fmaxf(fmaxf(pr[1][0], pr[1][1]), fmaxf(pr[1][2], pr[1][3])));
                    mx = row16_max(mx);
                    if (fr == 0 && fq == 0) atomicMax(kmaxp + (layer * NH + head) * 4 + wc, __float_as_uint(mx));
                }
            }
        }
    }
};
template <bool BASE_F32> struct EpiRes {
    static constexpr bool PERM = true, AFTER_DRAIN = false;
    const float* base_f; bf16_t* xb; float* ssq_out;
    __device__ __forceinline__ void operator()(const f32x4 (&acc)[2][2][4][2], const Unit& u, int wr, int wc, int fr, int fq) const {
        const int row0 = u.pm * BM + wr * 64 + fr, col0 = u.pn * BM + wc * 32 + 8 * fq;
#pragma unroll
        for (int ai = 0; ai < 2; ++ai)
#pragma unroll
            for (int m = 0; m < 4; ++m) {
                const int r = row0 + ai * HALF + m * 16;
                bf16_t* bo = xb + (size_t)r * DM + col0;
                float ss = 0.f;
#pragma unroll
                for (int bj = 0; bj < 2; ++bj) {
                    f32x4 b0, b1;
                    if constexpr (BASE_F32) { const float* bp = base_f + (size_t)r * DM + col0 + bj * HALF; b0 = *(const f32x4*)bp; b1 = *(const f32x4*)(bp + 4); }
                    else { const u32x4 w = *(const u32x4*)(bo + bj * HALF); b0 = (f32x4){bf_lo(w.x), bf_hi(w.x), bf_lo(w.y), bf_hi(w.y)}; b1 = (f32x4){bf_lo(w.z), bf_hi(w.z), bf_lo(w.w), bf_hi(w.w)}; }
                    const f32x4 v0 = b0 + acc[ai][bj][m][0], v1 = b1 + acc[ai][bj][m][1];
                    u32x4 w; w.x = cvt_pk_bf16(v0[0], v0[1]); w.y = cvt_pk_bf16(v0[2], v0[3]); w.z = cvt_pk_bf16(v1[0], v1[1]); w.w = cvt_pk_bf16(v1[2], v1[3]);
                    st16_wt(bo + bj * HALF, w);
                    ss += (v0[0] * v0[0] + v0[1] * v0[1]) + (v0[2] * v0[2] + v0[3] * v0[3]) + (v1[0] * v1[0] + v1[1] * v1[1]) + (v1[2] * v1[2] + v1[3] * v1[3]);
                }
                ss = swap32_sum(swap16_sum(ss));
                if (fq == 0) atomicAdd(ssq_out + r, ss);
            }
    }
};
struct EpiGU {
    static constexpr bool PERM = true, AFTER_DRAIN = false;
    bf16_t* h; const float* ssq;
    __device__ __forceinline__ void operator()(const f32x4 (&acc)[2][2][4][2], const Unit& u, int wr, int wc, int fr, int fq) const {
        const int row0 = u.pm * BM + wr * 64 + fr, col0 = u.pn * HALF + wc * 32 + 8 * fq;
#pragma unroll
        for (int ai = 0; ai < 2; ++ai)
#pragma unroll
            for (int m = 0; m < 4; ++m) {
                const int r = row0 + ai * HALF + m * 16;
                const float rs = rsqrtf(ssq[r] * (1.0f / DM) + EPS);
                float o[8];
#pragma unroll
                for (int n = 0; n < 2; ++n)
#pragma unroll
                    for (int i = 0; i < 4; ++i) {
                        const float g = acc[ai][0][m][n][i] * rs, up = acc[ai][1][m][n][i] * rs;
                        o[4 * n + i] = g * up * __builtin_amdgcn_rcpf(1.0f + ex2(-g * LOG2E));
                    }
                u32x4 w; w.x = cvt_pk_bf16(o[0], o[1]); w.y = cvt_pk_bf16(o[2], o[3]); w.z = cvt_pk_bf16(o[4], o[5]); w.w = cvt_pk_bf16(o[6], o[7]);
                *(u32x4*)(h + (size_t)r * DFF + col0) = w;
            }
    }
};

template <class Epi, class Sched, bool ALIGN_EPI = false, bool SP2 = false>
__device__ __forceinline__ void gemm_phase(LAS unsigned char* lds, const Gemm g, const Sched& S, const Epi& E) {
    int tid = threadIdx.x; asm volatile("" : "+v"(tid));
    const int wid = __builtin_amdgcn_readfirstlane(tid >> 6), lane = tid & 63, wr = wid >> 2, wc = wid & 3, fr = lane & 15, fq = lane >> 4;
    const int K = g.K, nt = K / BK;
    unsigned voffA[2], voffB[2];
#pragma unroll
    for (int i = 0; i < 2; ++i) { int R, C; stage_rc(tid * 16 + i * 8192, R, C); const int Rb = Epi::PERM ? ((R & ~31) + perm32(R & 31)) : R;
        voffA[i] = (unsigned)(R * K + C) * 2u; voffB[i] = (unsigned)(Rb * K + C) * 2u; }
    const size_t kstep = (size_t)(BK * 2);
    const size_t hstep = (size_t)HALF * K * 2;
    const size_t tstep = 2 * hstep;
    const unsigned ldsw = (unsigned)wid * 1024u;
    const int aoff = lds_byte(wr * 64 + fr, fq * 8), boff = lds_byte(wc * 32 + fr, fq * 8);
#define PG8_SA(b, h) (((b) * 2 + (h)) * HTB)
#define PG8_SB(b, h) ((4 + (b) * 2 + (h)) * HTB)
#define PG8_STAGE(bufoff, gbase, voff) do { _Pragma("unroll") for (int _i = 0; _i < 2; ++_i) \
        __builtin_amdgcn_global_load_lds((const unsigned*)((const char*)(gbase) + (voff)[_i]), (LAS unsigned*)(lds + (bufoff) + ldsw + _i * 8192), 16, 0, 0); } while (0)
#define PG8_LDA(dst, b, h) do { _Pragma("unroll") for (int m = 0; m < 4; ++m) _Pragma("unroll") for (int k = 0; k < 2; ++k) dst[m][k] = *(const LAS bf16x8*)(lds + PG8_SA(b, h) + aoff + m * 2048 + k * 1024); } while (0)
#define PG8_LDB(dst, b, h) do { _Pragma("unroll") for (int n = 0; n < 2; ++n) _Pragma("unroll") for (int k = 0; k < 2; ++k) dst[n][k] = *(const LAS bf16x8*)(lds + PG8_SB(b, h) + boff + n * 2048 + k * 1024); } while (0)
#define PG8_MMA(ai, bj, At, Bt) do { __builtin_amdgcn_s_setprio(1); _Pragma("unroll") for (int m = 0; m < 4; ++m) _Pragma("unroll") for (int n = 0; n < 2; ++n) _Pragma("unroll") for (int k = 0; k < 2; ++k) \
        acc[ai][bj][m][n] = __builtin_amdgcn_mfma_f32_16x16x32_bf16(Bt[n][k], At[m][k], acc[ai][bj][m][n], 0, 0, 0); __builtin_amdgcn_s_setprio(0); } while (0)
#define PG8_WAIT_V(n) asm volatile("s_waitcnt vmcnt(" #n ")" ::: "memory")
#define PG8_WAIT_L(n) asm volatile("s_waitcnt lgkmcnt(" #n ")" ::: "memory")
#define PG8_BAR __builtin_amdgcn_s_barrier()
#define PG8_SCHED __builtin_amdgcn_sched_barrier(0)
    Unit cur, nxt; int ui = 0;
    if (!S.next(0, cur)) return;
    f32x4 acc[2][2][4][2];
#pragma unroll
    for (int a = 0; a < 2; ++a)
#pragma unroll
        for (int b = 0; b < 2; ++b)
#pragma unroll
            for (int m = 0; m < 4; ++m)
#pragma unroll
                for (int n = 0; n < 2; ++n) acc[a][b][m][n] = (f32x4){0.f, 0.f, 0.f, 0.f};
    bf16x8 At[4][2], B0[2][2], B1[2][2];
    const char* cA = (const char*)g.A + (size_t)cur.pm * tstep; const char* cB = (const char*)g.Bt + (size_t)cur.pn * tstep;
    S.a_ready(cur);
    if constexpr (SP2) {
        PG8_STAGE(PG8_SB(0, 0), cB, voffB); PG8_STAGE(PG8_SB(0, 1), cB + hstep, voffB); PG8_STAGE(PG8_SA(0, 0), cA, voffA); PG8_STAGE(PG8_SA(0, 1), cA + hstep, voffA);
        if (wr == 1) PG8_BAR;
        PG8_WAIT_V(2); PG8_BAR;
        PG8_STAGE(PG8_SB(1, 0), cB + kstep, voffB); PG8_STAGE(PG8_SA(1, 0), cA + kstep, voffA); PG8_STAGE(PG8_SB(1, 1), cB + hstep + kstep, voffB);
        PG8_WAIT_V(6); PG8_BAR;
    } else {
        PG8_STAGE(PG8_SB(0, 0), cB, voffB); PG8_STAGE(PG8_SA(0, 0), cA, voffA); PG8_STAGE(PG8_SB(0, 1), cB + hstep, voffB); PG8_STAGE(PG8_SA(0, 1), cA + hstep, voffA);
        if (wr == 1) PG8_BAR;
        PG8_WAIT_V(4); PG8_BAR;
        PG8_STAGE(PG8_SB(1, 0), cB + kstep, voffB); PG8_STAGE(PG8_SA(1, 0), cA + kstep, voffA); PG8_STAGE(PG8_SB(1, 1), cB + hstep + kstep, voffB);
        PG8_WAIT_V(6); PG8_BAR;
    }
    for (;;) {
        const bool has_next = S.next(ui + 1, nxt);
        const char* nA = has_next ? (const char*)g.A + (size_t)nxt.pm * tstep : cA; const char* nB = has_next ? (const char*)g.Bt + (size_t)nxt.pn * tstep : cB;
        for (int t = 0; t < nt; t += 2) {
            const bool last = (t == nt - 2);
            const char* a1 = cA + (size_t)(t + 1) * kstep;
            const char* a2 = last ? nA : cA + (size_t)(t + 2) * kstep; const char* b2 = last ? nB : cB + (size_t)(t + 2) * kstep;
            const char* a3 = a2 + kstep; const char* b3 = b2 + kstep;
            if (last && has_next) S.a_ready(nxt);
            if constexpr (SP2) {
            PG8_LDB(B0, 0, 0); PG8_LDB(B1, 0, 1); PG8_SCHED; PG8_LDA(At, 0, 0); PG8_STAGE(PG8_SA(1, 1), a1 + hstep, voffA);
            PG8_WAIT_V(8); PG8_WAIT_L(0); PG8_BAR; PG8_MMA(0, 0, At, B0); PG8_MMA(0, 1, At, B1); PG8_BAR; PG8_SCHED;
            PG8_LDA(At, 0, 1); PG8_STAGE(PG8_SB(0, 0), b2, voffB); PG8_STAGE(PG8_SB(0, 1), b2 + hstep, voffB); PG8_STAGE(PG8_SA(0, 0), a2, voffA);
            PG8_WAIT_V(8); PG8_WAIT_L(0); PG8_BAR; PG8_MMA(1, 0, At, B0); PG8_MMA(1, 1, At, B1); PG8_BAR; PG8_SCHED;
            PG8_LDB(B0, 1, 0); PG8_LDB(B1, 1, 1); PG8_SCHED; PG8_LDA(At, 1, 0); PG8_STAGE(PG8_SA(0, 1), a2 + hstep, voffA);
            PG8_WAIT_V(8); PG8_WAIT_L(0); PG8_BAR; PG8_MMA(0, 0, At, B0); PG8_MMA(0, 1, At, B1); PG8_BAR; PG8_SCHED;
            PG8_LDA(At, 1, 1); PG8_STAGE(PG8_SB(1, 0), b3, voffB); PG8_STAGE(PG8_SB(1, 1), b3 + hstep, voffB); PG8_STAGE(PG8_SA(1, 0), a3, voffA);
            PG8_WAIT_V(8); PG8_WAIT_L(0); PG8_BAR; PG8_MMA(1, 0, At, B0); PG8_MMA(1, 1, At, B1); PG8_BAR; PG8_SCHED;
            } else {
            PG8_LDB(B0, 0, 0); PG8_SCHED; PG8_LDA(At, 0, 0); PG8_STAGE(PG8_SA(1, 1), a1 + hstep, voffA);
            PG8_WAIT_L(8); PG8_BAR; PG8_WAIT_L(0); PG8_MMA(0, 0, At, B0); PG8_BAR; PG8_SCHED;
            PG8_LDB(B1, 0, 1); PG8_STAGE(PG8_SB(0, 0), b2, voffB);
            PG8_BAR; PG8_WAIT_L(0); PG8_MMA(0, 1, At, B1); PG8_BAR;
            PG8_LDA(At, 0, 1); PG8_STAGE(PG8_SA(0, 0), a2, voffA);
            PG8_BAR; PG8_WAIT_L(0); PG8_MMA(1, 0, At, B0); PG8_BAR; PG8_SCHED;
            PG8_STAGE(PG8_SB(0, 1), b2 + hstep, voffB);
            PG8_WAIT_V(6); PG8_BAR; PG8_MMA(1, 1, At, B1); PG8_BAR;
            PG8_LDB(B0, 1, 0); PG8_SCHED; PG8_LDA(At, 1, 0); PG8_STAGE(PG8_SA(0, 1), a2 + hstep, voffA);
            PG8_WAIT_L(8); PG8_BAR; PG8_WAIT_L(0); PG8_MMA(0, 0, At, B0); PG8_BAR; PG8_SCHED;
            PG8_LDB(B1, 1, 1); PG8_STAGE(PG8_SB(1, 0), b3, voffB);
            PG8_BAR; PG8_WAIT_L(0); PG8_MMA(0, 1, At, B1); PG8_BAR;
            PG8_LDA(At, 1, 1); PG8_STAGE(PG8_SA(1, 0), a3, voffA);
            PG8_BAR; PG8_WAIT_L(0); PG8_MMA(1, 0, At, B0); PG8_BAR; PG8_SCHED;
            PG8_STAGE(PG8_SB(1, 1), b3 + hstep, voffB);
            PG8_WAIT_V(6); PG8_BAR; PG8_MMA(1, 1, At, B1); PG8_BAR;
            }
        }
        if constexpr (ALIGN_EPI) { if (wr == 0) PG8_BAR; }
        if constexpr (!Epi::AFTER_DRAIN) { E(acc, cur, wr, wc, fr, fq); S.done(cur); }
        if (!has_next) break;
#pragma unroll
        for (int a = 0; a < 2; ++a)
#pragma unroll
            for (int b = 0; b < 2; ++b)
#pragma unroll
                for (int m = 0; m < 4; ++m)
#pragma unroll
                    for (int n = 0; n < 2; ++n) acc[a][b][m][n] = (f32x4){0.f, 0.f, 0.f, 0.f};
        cur = nxt; cA = nA; cB = nB; ++ui;
        if constexpr (ALIGN_EPI) { if (wr == 1) PG8_BAR; }
    }
    PG8_WAIT_V(0);
    if constexpr (!ALIGN_EPI) { if (wr == 0) PG8_BAR; }
    PG8_BAR;
#undef PG8_SA
#undef PG8_SB
#undef PG8_STAGE
#undef PG8_LDA
#undef PG8_LDB
#undef PG8_MMA
#undef PG8_WAIT_V
#undef PG8_WAIT_L
#undef PG8_BAR
#undef PG8_SCHED
}
}

#define XB_TMO      128
#define XB_XCNT(j)  (256  + 64 * (j))
#define XB_XSUB(j)  (1280 + 64 * (j))
#define XB_XGEN(j)  (2304 + 64 * (j))
#define XB_TOP      3328
#define XB_TOPGEN   3392
#define XCD_BAR_WORDS 3456
#define XB_SPIN_CAP (1u << 18)
__device__ __forceinline__ unsigned xb_ld(unsigned* p)              { return __hip_atomic_load(p, __ATOMIC_RELAXED, __HIP_MEMORY_SCOPE_AGENT); }
__device__ __forceinline__ unsigned xb_add(unsigned* p, unsigned v) { return __hip_atomic_fetch_add(p, v, __ATOMIC_RELAXED, __HIP_MEMORY_SCOPE_AGENT); }
__device__ __forceinline__ unsigned xb_xcc_id() { return (unsigned)__builtin_amdgcn_s_getreg((3 << 11) | 20) & 0xFu; }
#define XB_SPIN(cond, bar) do { unsigned _sp = 0; while (cond) { __builtin_amdgcn_s_sleep(1); \
    if ((++_sp & 255u) == 0u) { if (xb_ld(&(bar)[XB_TMO])) break; if (_sp > XB_SPIN_CAP) { atomicAdd(&(bar)[XB_TMO], 1u); break; } } } } while (0)
struct XcdBarrier { unsigned* bar; unsigned x; volatile LAS unsigned* st; };
__device__ __forceinline__ XcdBarrier xcd_barrier_post(unsigned* bar, volatile LAS unsigned* st) {
    XcdBarrier b; b.bar = bar; b.x = xb_xcc_id(); b.st = st;
    if (threadIdx.x == 0) (void)xb_add(&bar[XB_XCNT(b.x)], 1u);
    return b;
}
__device__ __forceinline__ void xcd_barrier_complete(unsigned* bar, unsigned x, unsigned& nloc, unsigned& nx) {
    const unsigned G = gridDim.x * gridDim.y * gridDim.z;
    unsigned sum, cnt, mine, sp = 0u;
    for (;;) {
        sum = 0u; cnt = 0u; mine = 0u;
#pragma unroll
        for (unsigned j = 0; j < 16; ++j) { const unsigned c = xb_ld(&bar[XB_XCNT(j)]); sum += c; cnt += (c > 0u) ? 1u : 0u; mine = (j == x) ? c : mine; }
        if (sum == G) break;
        __builtin_amdgcn_s_sleep(1);
        if ((++sp & 255u) == 0u) { if (xb_ld(&bar[XB_TMO])) break; if (sp > XB_SPIN_CAP) { atomicAdd(&bar[XB_TMO], 1u); break; } }
    }
    nloc = mine > 0u ? mine : 1u; nx = cnt > 0u ? cnt : 1u;
}
__device__ __forceinline__ void xcd_barrier(const XcdBarrier& b) {
    asm volatile("s_waitcnt vmcnt(0)" ::: "memory");
    __syncthreads();
    if (threadIdx.x == 0) {
        long zb_ = 0; asm volatile("" : "+s"(zb_)); unsigned* bar = b.bar + zb_;
        unsigned bx_ = b.x; asm volatile("" : "+s"(bx_));
        __builtin_amdgcn_s_waitcnt(0);
        unsigned nloc = b.st[0], nx = b.st[1];
        if (nloc == 0u) { xcd_barrier_complete(bar, bx_, nloc, nx); b.st[0] = nloc; b.st[1] = nx; }
        const unsigned old = xb_add(&bar[XB_XSUB(bx_)], 1u);
        const unsigned gen = old / nloc;
        if (old + 1u == (gen + 1u) * nloc) {
            __builtin_amdgcn_fence(__ATOMIC_RELEASE, "agent");
            asm volatile("s_waitcnt vmcnt(0)" ::: "memory");
            const unsigned og = xb_add(&bar[XB_TOP], 1u);
            const unsigned tg = og / nx;
            if (og + 1u == (tg + 1u) * nx) xb_add(&bar[XB_TOPGEN], 1u);
            else XB_SPIN(xb_ld(&bar[XB_TOPGEN]) == tg, bar);
            __builtin_amdgcn_fence(__ATOMIC_ACQUIRE, "agent");
            xb_add(&bar[XB_XGEN(bx_)], 1u);
            asm volatile("s_waitcnt vmcnt(0)" ::: "memory");
        } else {
            XB_SPIN(xb_ld(&bar[XB_XGEN(bx_)]) == gen, bar);
            __builtin_amdgcn_fence(__ATOMIC_ACQUIRE, "agent");
            asm volatile("s_waitcnt vmcnt(0)" ::: "memory");
        }
    }
    __syncthreads();
}

#define KSWZ(row, colB) ((row) * 256 + ((colB) ^ (((row) & 7) << 4)))
#define SBAR() __builtin_amdgcn_sched_barrier(0)
__device__ __forceinline__ int crow(int r, int hi) { return (r & 3) + 8 * (r >> 2) + 4 * hi; }
__device__ __forceinline__ int v_st(int k, int c) { const int kk = (k & ~0xC) | ((k & 4) << 1) | ((k & 8) >> 1); return ((kk >> 3) * 4 + (c >> 5)) * 512 + ((kk & 7) * 32 + (c & 31)) * 2; }
__device__ __forceinline__ int v_rd_base(int lane) { return ((lane & 3) << 3) | (((lane >> 2) & 3) << 6) | (((lane >> 4) & 1) << 5) | (((lane >> 5) & 1) << 8); }
constexpr int v_rd_off(int d0, int ks, int half) { return d0 * 512 + ks * 4096 + half * 2048; }
template <int OFF> __device__ __forceinline__ s16x4 tr_read(unsigned vb) {
    s16x4 r; asm volatile("ds_read_b64_tr_b16 %0, %1 offset:%2" : "=&v"(r) : "v"(vb), "i"(OFF) : "memory"); return r;
}
template <int D0> __device__ __forceinline__ void pv_one(f32x16& od, unsigned vb, bf16x8 pa0, bf16x8 pa1, bf16x8 pa2, bf16x8 pa3) {
    const s16x4 l0 = tr_read<v_rd_off(D0, 0, 0)>(vb), h0 = tr_read<v_rd_off(D0, 0, 1)>(vb), l1 = tr_read<v_rd_off(D0, 1, 0)>(vb), h1 = tr_read<v_rd_off(D0, 1, 1)>(vb);
    const s16x4 l2 = tr_read<v_rd_off(D0, 2, 0)>(vb), h2 = tr_read<v_rd_off(D0, 2, 1)>(vb), l3 = tr_read<v_rd_off(D0, 3, 0)>(vb), h3 = tr_read<v_rd_off(D0, 3, 1)>(vb);
    asm volatile("s_waitcnt lgkmcnt(0)" ::: "memory"); SBAR();
#define PK(L, H) (bf16x8){L[0], L[1], L[2], L[3], H[0], H[1], H[2], H[3]}
    od = __builtin_amdgcn_mfma_f32_32x32x16_bf16(pa0, PK(l0, h0), od, 0, 0, 0);
    od = __builtin_amdgcn_mfma_f32_32x32x16_bf16(pa1, PK(l1, h1), od, 0, 0, 0);
    od = __builtin_amdgcn_mfma_f32_32x32x16_bf16(pa2, PK(l2, h2), od, 0, 0, 0);
    od = __builtin_amdgcn_mfma_f32_32x32x16_bf16(pa3, PK(l3, h3), od, 0, 0, 0);
#undef PK
}
#define PK4(P, BASE, OUT) do { unsigned a0 = cvt_pk_bf16(P[BASE + 0], P[BASE + 1]), a1 = cvt_pk_bf16(P[BASE + 2], P[BASE + 3]);   \
    unsigned b0 = cvt_pk_bf16(P[BASE + 4], P[BASE + 5]), b1 = cvt_pk_bf16(P[BASE + 6], P[BASE + 7]);                              \
    auto r0 = __builtin_amdgcn_permlane32_swap(a0, b0, false, false); auto r1 = __builtin_amdgcn_permlane32_swap(a1, b1, false, false); \
    u32x4 w = {r0[0], r1[0], r0[1], r1[1]}; OUT = __builtin_bit_cast(bf16x8, w); } while (0)

constexpr int AL_KV = 0  , AL_WS = 65536  , AL_CQ = 67584  , AL_CK = 69632  ,
              AL_FLAG = 70656  , AL_Q = 73728  , AL_Q7 = 135168;

struct AttnItem {
    int sb;
    int nq, t0, Kc, Knew_cnt;
    const bf16_t* Q;
    const float* Kcache; const float* Vcache;
    const bf16_t* Knew; const bf16_t* Vnew;
    const float* Lcache; const float* Lnew;
    float kn2, kn2b;
    bf16_t* O;
};

__device__ __forceinline__ bf16x8 cvt8(const f32x4 a, const f32x4 b) {
    u32x4 w = {cvt_pk_bf16(a[0], a[1]), cvt_pk_bf16(a[2], a[3]), cvt_pk_bf16(b[0], b[1]), cvt_pk_bf16(b[2], b[3])}; return __builtin_bit_cast(bf16x8, w);
}
template <int SB> __device__ __forceinline__ void attn_item(const AttnItem& it, LAS unsigned char* lds) {
    int tid = threadIdx.x; asm volatile("" : "+v"(tid));
    const int lane = tid & 63, r32 = lane & 31, hi = lane >> 5; const int wid = __builtin_amdgcn_readfirstlane(tid >> 6);
    const int hs = wid >> 2, rg = wid & 3;
    LAS unsigned char* K_lds = lds + AL_KV + hs * 32768; LAS unsigned char* V_lds = K_lds + 16384;
    LAS float* wsf = (LAS float*)(lds + AL_WS) + wid * 64;
    LAS float* cq_l = (LAS float*)(lds + AL_CQ) + hs * 256; LAS float* ck_l = (LAS float*)(lds + AL_CK) + hs * 128; volatile LAS unsigned* flag_l = (volatile LAS unsigned*)(lds + AL_FLAG);
    const bool active = (32 * rg < it.nq);
    constexpr int sb = SB;
    LAS unsigned char* Q_lds = lds + (wid == 7 ? AL_Q7 : AL_Q + wid * 8192);
    const float* Lnew_h = it.Lnew + hs; const float* Lcache_h = it.Lcache + hs;
    float qn = 0.f, cq = 0.f;
    if (active) {
        const bf16_t* Qw = it.Q + (size_t)(32 * rg + r32) * NPROJ + hs * HD + hi * 8;
        float s2 = 0.f;
#pragma unroll
        for (int d0 = 0; d0 < 8; ++d0) { const bf16x8 qv = *(const bf16x8*)(Qw + d0 * 16);
            *(LAS bf16x8*)(Q_lds + KSWZ(r32, (d0 * 16 + hi * 8) * 2)) = qv;
            const u32x4 w = __builtin_bit_cast(u32x4, qv);
#pragma unroll
            for (int i = 0; i < 4; ++i) { const float a = bf_lo(w[i]), b = bf_hi(w[i]); s2 += a * a + b * b; } }
        s2 += partner32(s2, hi);
        qn = sqrtf(s2);
    }
    if (!sb) {
        if (rg == 3) {
            float v[4]; float s = 0.f;
#pragma unroll
            for (int i = 0; i < 4; ++i) { const int idx = 4 * lane + i; const int pn = it.t0 - it.Kc + idx; v[i] = (idx < it.nq) ? Lnew_h[(size_t)pn * 6] : 0.f; s += v[i]; }
            float incl = s;
#pragma unroll
            for (int o = 1; o < 64; o <<= 1) { const float t = bperm((lane - o) & 63, incl); if (lane >= o) incl += t; }
            float run = incl - s;
#pragma unroll
            for (int i = 0; i < 4; ++i) { run += v[i]; cq_l[4 * lane + i] = run; }
        }
        __syncthreads();
        cq = cq_l[32 * rg + r32];
    }
    const float knorm = sqrtf(hs ? it.kn2b : it.kn2) * 1.01f;
    float R = 0.f, m_run = -1e30f, l_run = 0.f, tot = 0.f;
    f32x16 o[4];
#pragma unroll
    for (int d = 0; d < 4; ++d) o[d] = f32x16{};
    bool done = !active;
    const int qpos = it.t0 + 32 * rg + r32, qpos_max = it.t0 + 32 * rg + 31;
    const int sr = (tid & 255) >> 4, sc = (tid & 15) * 8;
    const unsigned vb = (unsigned)(uintptr_t)V_lds + (unsigned)v_rd_base(lane);
    const int jstart = (it.t0 + it.nq - 1) >> 6;
    f32x4 ra[4];
    const f32x4 zero4 = {0.f, 0.f, 0.f, 0.f};
    const int kst = KSWZ(sr, sc * 2), vst = v_st(sr, sc);
    const int lrow = lane >> 4, lch = lane & 15;
#define NTL(p) __builtin_nontemporal_load((const f32x4*)(p))
#define V_PRELOAD(jj) do { const int j_ = (jj); \
        if (64 * j_ >= it.Kc) { \
            const int pn0_ = 64 * j_ - it.Kc; const unsigned off_ = (unsigned)(pn0_ + sr) * (unsigned)(NPROJ * 2) + (unsigned)(sc + hs * HD) * 2u; const char* vn_ = (const char*)it.Vnew; \
            ra[0] = zero4; ra[1] = zero4; ra[2] = zero4; ra[3] = zero4; \
            if (pn0_ < it.Knew_cnt) { ra[0] = *(const f32x4*)(vn_ + off_); ra[1] = *(const f32x4*)(vn_ + 16 * NPROJ * 2 + off_); } \
            if (pn0_ + 32 < it.Knew_cnt) { ra[2] = *(const f32x4*)(vn_ + 32 * NPROJ * 2 + off_); ra[3] = *(const f32x4*)(vn_ + 48 * NPROJ * 2 + off_); } } } while (0)
#define K_STAGE(jj) do { const int j_ = (jj); \
        if (64 * j_ >= it.Kc && 64 * j_ - it.Kc + 64 <= it.Knew_cnt) {     \
            const char* kn_ = (const char*)it.Knew + ((size_t)(64 * j_ - it.Kc + 16 * rg) * NPROJ + hs * HD) * 2; LAS unsigned char* kd_ = K_lds + rg * 4096; \
            const unsigned oe_ = (unsigned)lrow * (unsigned)(NPROJ * 2) + (unsigned)((lch ^ lrow) * 16), oo_ = (unsigned)(lrow + 4) * (unsigned)(NPROJ * 2) + (unsigned)((lch ^ (lrow + 4)) * 16); \
            __builtin_amdgcn_global_load_lds((const unsigned*)(kn_ + oe_), (LAS unsigned*)(kd_), 16, 0, 0); \
            __builtin_amdgcn_global_load_lds((const unsigned*)(kn_ + oo_), (LAS unsigned*)(kd_ + 1024), 16, 0, 0); \
            __builtin_amdgcn_global_load_lds((const unsigned*)(kn_ + 8 * NPROJ * 2 + oe_), (LAS unsigned*)(kd_ + 2048), 16, 0, 0); \
            __builtin_amdgcn_global_load_lds((const unsigned*)(kn_ + 8 * NPROJ * 2 + oo_), (LAS unsigned*)(kd_ + 3072), 16, 0, 0); \
        } else if (64 * j_ < it.Kc) { \
            const char* kc_ = (const char*)it.Kcache; \
            _Pragma("unroll 1") for (int q_ = 0; q_ < 4; ++q_) { const unsigned off_ = (unsigned)(64 * j_ + sr + 16 * q_) * 3072u + (unsigned)(sc + hs * HD) * 4u; \
                const f32x4 a0_ = NTL(kc_ + off_), a1_ = NTL(kc_ + off_ + 16); *(LAS bf16x8*)(K_lds + kst + q_ * 4096) = cvt8(a0_, a1_); } \
        } else { \
            const int pn0_ = 64 * j_ - it.Kc; const unsigned off_ = (unsigned)(pn0_ + sr) * (unsigned)(NPROJ * 2) + (unsigned)(sc + hs * HD) * 2u; const char* kn_ = (const char*)it.Knew; \
            _Pragma("unroll 1") for (int q_ = 0; q_ < 4; ++q_) { f32x4 t_ = zero4; if (pn0_ + 32 * (q_ >> 1) < it.Knew_cnt) t_ = *(const f32x4*)(kn_ + q_ * 16 * NPROJ * 2 + off_); \
                *(LAS bf16x8*)(K_lds + kst + q_ * 4096) = __builtin_bit_cast(bf16x8, t_); } \
        } } while (0)
    K_STAGE(jstart); V_PRELOAD(jstart);
    for (int j = jstart; j >= 0; --j) {
        if (64 * j < it.Kc) {
            const char* vc = (const char*)it.Vcache;
#pragma unroll 1
            for (int q = 0; q < 4; ++q) {
                const unsigned off = (unsigned)(64 * j + sr + 16 * q) * 3072u + (unsigned)(sc + hs * HD) * 4u;
                const f32x4 c0 = NTL(vc + off), c1 = NTL(vc + off + 16);
                *(LAS bf16x8*)(V_lds + vst + q * 4096) = cvt8(c0, c1);
            }
        } else {
#pragma unroll
            for (int q = 0; q < 4; ++q) *(LAS bf16x8*)(V_lds + vst + q * 4096) = __builtin_bit_cast(bf16x8, ra[q]);
        }
        if (!sb && rg == 3) {
            const int p = 64 * j + lane;
            if (64 * j >= it.t0) {
                const int idx = p - it.t0;
                ck_l[lane] = (idx < it.nq) ? cq_l[idx] : 0.f;
                if (lane == 0) ck_l[64] = (64 * j > it.t0) ? cq_l[64 * j - 1 - it.t0] : 0.f;
            } else {
                float L;
                if (p < it.Kc) L = Lcache_h[(size_t)p * 6]; else L = Lnew_h[(size_t)(p - it.Kc) * 6];
                float suf = L;
#pragma unroll
                for (int o = 1; o < 64; o <<= 1) { const float t = bperm((lane + o) & 63, suf); if (lane + o < 64) suf += t; }
                ck_l[lane] = tot - (suf - L);
                const float total = __builtin_amdgcn_readfirstlane(suf);
                tot -= total;
                if (lane == 0) ck_l[64] = tot;
            }
        }
        VM_WAIT(); __syncthreads();
        if (j > 0) V_PRELOAD(j - 1);
        const bool comp = !done && 64 * j <= qpos_max;
        f32x16 p0 = f32x16{}, p1 = f32x16{};
        if (comp) {
            const int swz = (r32 & 7) << 4;
#pragma unroll
            for (int d = 0; d < 4; ++d) { const int ka = r32 * 256 + ((d * 32 + hi * 16) ^ swz);
#pragma unroll
                for (int dh = 0; dh < 2; ++dh) {
                    const bf16x8 b0 = *(const LAS bf16x8*)(K_lds + ka + dh * 128);
                    const bf16x8 b1 = *(const LAS bf16x8*)(K_lds + ka + dh * 128 + 8192);
                    const bf16x8 qf = *(const LAS bf16x8*)(Q_lds + ka + dh * 128);
                    p0 = __builtin_amdgcn_mfma_f32_32x32x16_bf16(b0, qf, p0, 0, 0, 0);
                    p1 = __builtin_amdgcn_mfma_f32_32x32x16_bf16(b1, qf, p1, 0, 0, 0); } }
        }
        __syncthreads();
        if (j > 0) K_STAGE(j - 1);
        if (comp) {
            const int kb = 64 * j + 4 * hi;
            bf16x8 pa0, pa1, pa2, pa3;
            if (sb) {
                float run = R;
#define SB_GROUP(P, g, KOFF) do { float z_[4], l_[4]; \
                    _Pragma("unroll") for (int i_ = 0; i_ < 4; ++i_) { const float z = P[4 * (g) + i_] * QK_SCALE; const float sp = lg2(1.f + ex2(-fabsf(z) * LOG2E)) * LN2; \
                        const bool ok = (kb + (KOFF) + 8 * (g) + i_) < qpos; l_[i_] = ok ? -(fmaxf(z, 0.f) + sp) : 0.f; z_[i_] = ok ? z : -INFINITY; } \
                    const float gs = (l_[0] + l_[1]) + (l_[2] + l_[3]); const float gp = partner32(gs, hi); \
                    float lat = run + (hi ? 0.f : gp); \
                    P[4 * (g) + 3] = ex2((z_[3] + l_[3] + lat) * LOG2E); lat += l_[3]; \
                    P[4 * (g) + 2] = ex2((z_[2] + l_[2] + lat) * LOG2E); lat += l_[2]; \
                    P[4 * (g) + 1] = ex2((z_[1] + l_[1] + lat) * LOG2E); lat += l_[1]; \
                    P[4 * (g) + 0] = ex2((z_[0] + l_[0] + lat) * LOG2E); \
                    run += gs + gp; SBAR(); } while (0)
                SB_GROUP(p1, 3, 32); SB_GROUP(p1, 2, 32); SB_GROUP(p1, 1, 32); SB_GROUP(p1, 0, 32);
                SB_GROUP(p0, 3, 0); SB_GROUP(p0, 2, 0); SB_GROUP(p0, 1, 0); SB_GROUP(p0, 0, 0);
#undef SB_GROUP
                R = run;
                PK4(p0, 0, pa0); PK4(p0, 8, pa1); PK4(p1, 0, pa2); PK4(p1, 8, pa3);
                done = __all(R < -EXIT_T);
            } else {
                float pmax = -INFINITY;
#pragma unroll
                for (int g = 0; g < 4; ++g) {
                    const f32x4 c0 = *(const LAS f32x4*)(ck_l + 8 * g + 4 * hi), c1 = *(const LAS f32x4*)(ck_l + 32 + 8 * g + 4 * hi);
#pragma unroll
                    for (int i = 0; i < 4; ++i) { const int r = 4 * g + i; const int kp = kb + i + 8 * g;
                        const float s0 = p0[r] * QK_SCALE + (cq - c0[i]), s1 = p1[r] * QK_SCALE + (cq - c1[i]);
                        p0[r] = (kp <= qpos) ? s0 : -INFINITY; p1[r] = (kp + 32 <= qpos) ? s1 : -INFINITY;
                        pmax = fmaxf(pmax, fmaxf(p0[r], p1[r])); }
                    SBAR();
                }
                pmax = fmaxf(pmax, partner32(pmax, hi));
                const float mnew = fmaxf(m_run, pmax);
                const float alpha = ex2((m_run - mnew) * LOG2E);
                float ps = 0.f;
#pragma unroll
                for (int r = 0; r < 16; ++r) { p0[r] = ex2((p0[r] - mnew) * LOG2E); p1[r] = ex2((p1[r] - mnew) * LOG2E); ps += p0[r] + p1[r]; if ((r & 3) == 3) SBAR(); }
                ps += partner32(ps, hi);
                l_run = l_run * alpha + ps; m_run = mnew;
                if (__any(alpha != 1.f)) {
                    if (hi == 0) wsf[r32] = alpha;
                    LDS_WAIT();
#pragma unroll
                    for (int r = 0; r < 16; ++r) { const float a = wsf[crow(r, hi)];
#pragma unroll
                        for (int d = 0; d < 4; ++d) o[d][r] *= a; }
                }
                PK4(p0, 0, pa0); PK4(p0, 8, pa1); PK4(p1, 0, pa2); PK4(p1, 8, pa3);
                const float zb = qn * knorm * QK_SCALE + (cq - ck_l[64]);
                done = __all(zb - m_run < -EXIT_T);
            }
            pv_one<0>(o[0], vb, pa0, pa1, pa2, pa3); pv_one<1>(o[1], vb, pa0, pa1, pa2, pa3); pv_one<2>(o[2], vb, pa0, pa1, pa2, pa3); pv_one<3>(o[3], vb, pa0, pa1, pa2, pa3);
        }
        if (lane == 0) flag_l[wid] = done ? 1u : 0u;
        __syncthreads();
        unsigned all = 1u;
#pragma unroll
        for (int w = 0; w < 8; ++w) all &= flag_l[w];
        if (all) break;
    }
    if (active) {
        float rli[16];
        if (!sb) {
            if (hi == 0) wsf[32 + r32] = 1.0f / l_run;
            LDS_WAIT();
#pragma unroll
            for (int r = 0; r < 16; ++r) rli[r] = wsf[32 + crow(r, hi)];
        } else {
#pragma unroll
            for (int r = 0; r < 16; ++r) rli[r] = 1.f;
        }
        bf16_t* Ow = it.O + (size_t)(32 * rg) * DM + hs * HD;
#pragma unroll
        for (int r = 0; r < 16; ++r) { const int orow = crow(r, hi);
#pragma unroll
            for (int d0 = 0; d0 < 4; ++d0) { const unsigned w = cvt_pk_bf16(o[d0][r] * rli[r], 0.f); Ow[(size_t)orow * DM + d0 * 32 + r32] = (bf16_t)(w & 0xffffu); } }
    }
    VM_WAIT(); __syncthreads();
#undef V_PRELOAD
#undef K_STAGE
#undef NTL
}

__device__ __forceinline__ void conv_item(int cb, int layer, const bf16_t* proj, bf16_t* Y, const float* state_conv, const float* conv_w, float* out) {
    int tid = threadIdx.x; asm volatile("" : "+v"(tid));
    const int lane = tid & 63, wid = tid >> 6;
    const int c8 = lane * 8, g0 = 64 * cb + 8 * wid;
    const bool sample = g0 >= SEQ;
    const int b = sample ? (g0 - SEQ) / DSEQ : 0;
    const int seq0 = sample ? SEQ + DSEQ * b : 0, seq_end = sample ? seq0 + DSEQ : SEQ;
    float w0[8], w1[8], w2[8], um2[8], um1[8];
    { const float* cw = conv_w + (size_t)layer * 3 * CONVD + c8;
      const f32x4 a0 = *(const f32x4*)cw, a1 = *(const f32x4*)(cw + 4), b0 = *(const f32x4*)(cw + CONVD), b1 = *(const f32x4*)(cw + CONVD + 4), c0 = *(const f32x4*)(cw + 2 * CONVD), c1 = *(const f32x4*)(cw + 2 * CONVD + 4);
#pragma unroll
      for (int i = 0; i < 4; ++i) { w0[i] = a0[i]; w0[4 + i] = a1[i]; w1[i] = b0[i]; w1[4 + i] = b1[i]; w2[i] = c0[i]; w2[4 + i] = c1[i]; } }
    auto load_u = [&](int t, float (&u)[8]) {
        const u32x4 gc = *(const u32x4*)(proj + (size_t)t * NPROJ + C_GC + c8), hc = *(const u32x4*)(proj + (size_t)t * NPROJ + C_HC + c8);
#pragma unroll
        for (int i = 0; i < 4; ++i) { u[2 * i] = bf_lo(gc[i]) * bf_lo(hc[i]); u[2 * i + 1] = bf_hi(gc[i]) * bf_hi(hc[i]); }
    };
    if (g0 == seq0) {
        if (sample) { const float* st = state_conv + ((size_t)(layer * DB + b) * 2) * CONVD + c8;
            const f32x4 a0 = *(const f32x4*)st, a1 = *(const f32x4*)(st + 4), b0 = *(const f32x4*)(st + CONVD), b1 = *(const f32x4*)(st + CONVD + 4);
#pragma unroll
            for (int i = 0; i < 4; ++i) { um2[i] = a0[i]; um2[4 + i] = a1[i]; um1[i] = b0[i]; um1[4 + i] = b1[i]; } }
        else {
#pragma unroll
            for (int i = 0; i < 8; ++i) { um2[i] = 0.f; um1[i] = 0.f; } }
    } else { load_u(g0 - 2, um2); load_u(g0 - 1, um1); }
#pragma unroll 1
    for (int t = g0; t < g0 + 8; ++t) {
        float u[8]; load_u(t, u);
        const u32x4 gb = *(const u32x4*)(proj + (size_t)t * NPROJ + C_GB + c8);
        float y[8];
#pragma unroll
        for (int i = 0; i < 4; ++i) {
            y[2 * i] = bf_lo(gb[i]) * (w0[2 * i] * um2[2 * i] + w1[2 * i] * um1[2 * i] + w2[2 * i] * u[2 * i]);
            y[2 * i + 1] = bf_hi(gb[i]) * (w0[2 * i + 1] * um2[2 * i + 1] + w1[2 * i + 1] * um1[2 * i + 1] + w2[2 * i + 1] * u[2 * i + 1]);
        }
        u32x4 w; w.x = cvt_pk_bf16(y[0], y[1]); w.y = cvt_pk_bf16(y[2], y[3]); w.z = cvt_pk_bf16(y[4], y[5]); w.w = cvt_pk_bf16(y[6], y[7]);
        *(u32x4*)(Y + (size_t)t * DM + c8) = w;
        if (t >= seq_end - 2) {
            const int which = t - (seq_end - 2);
            float* dst = sample ? out + O_SCONV + ((size_t)(layer * DB + b) * 2 + which) * CONVD + c8 : out + O_PCONV + ((size_t)layer * 2 + which) * CONVD + c8;
            *(f32x4*)dst = (f32x4){u[0], u[1], u[2], u[3]}; *(f32x4*)(dst + 4) = (f32x4){u[4], u[5], u[6], u[7]};
        }
#pragma unroll
        for (int i = 0; i < 8; ++i) { um2[i] = um1[i]; um1[i] = u[i]; }
    }
}


struct SkProj {
    bf16_t* proj; const float* ssq; float* out; int layer; unsigned* kmaxs;
    __device__ __forceinline__ void operator()(const f32x16& acc, int n0, int row, int r32, int hi) const {
        const float rs = rsqrtf(ssq[SEQ + row] * (1.0f / DM) + EPS);
        int seg = -1, segcol = 0;
        if (n0 >= C_SK && n0 < C_FQ) { seg = (n0 - C_SK) / 768; segcol = (n0 - C_SK) % 768; }
        else if (n0 >= C_FK) { seg = 2 + (n0 - C_FK) / 768; segcol = (n0 - C_FK) % 768; }
        bf16_t* pr = proj + (size_t)(SEQ + row) * NPROJ + n0 + 4 * hi;
        float* orow = out + O_SSBK + (size_t)(seg < 0 ? 0 : seg) * S_KV_STRIDE + ((size_t)layer * NSMP + row) * 768 + segcol + 4 * hi;
        float ss = 0.f;
#pragma unroll
        for (int g = 0; g < 4; ++g) {
            const f32x4 v = {acc[4 * g] * rs, acc[4 * g + 1] * rs, acc[4 * g + 2] * rs, acc[4 * g + 3] * rs};
            u32x2 w; w.x = cvt_pk_bf16(v[0], v[1]); w.y = cvt_pk_bf16(v[2], v[3]);
            *(u32x2*)(pr + 8 * g) = w;
            if (seg >= 0) *(f32x4*)(orow + 8 * g) = v;
            ss += (v[0] * v[0] + v[1] * v[1]) + (v[2] * v[2] + v[3] * v[3]);
        }
        if (n0 >= C_FK && n0 < C_FV) {
            ss = swap32_sum(ss);
            float mx = row16_max(ss);
            { auto rr = __builtin_amdgcn_permlane16_swap(__float_as_uint(mx), __float_as_uint(mx), false, false); mx = fmaxf(__uint_as_float(rr[0]), __uint_as_float(rr[1])); }
            const int head = (n0 - C_FK) / HD, part = ((n0 - C_FK) % HD) / 32, b = row >> 5;
            if (r32 == 0 && hi == 0) atomicMax(kmaxs + ((layer * DB + b) * NH + head) * 4 + part, __float_as_uint(mx));
        }
    }
};
template <bool BASE_F32> struct SkRes {
    const float* base_f; bf16_t* xb; float* ssq_out;
    __device__ __forceinline__ void operator()(const f32x16& acc, int n0, int row, int r32, int hi) const {
        bf16_t* bo = xb + (size_t)(SEQ + row) * DM + n0 + 4 * hi;
        float ss = 0.f;
#pragma unroll
        for (int g = 0; g < 4; ++g) {
            f32x4 b;
            if constexpr (BASE_F32) b = *(const f32x4*)(base_f + (size_t)row * DM + n0 + 4 * hi + 8 * g);
            else { const u32x2 w = *(const u32x2*)(bo + 8 * g); b = (f32x4){bf_lo(w.x), bf_hi(w.x), bf_lo(w.y), bf_hi(w.y)}; }
            const f32x4 v = {b[0] + acc[4 * g], b[1] + acc[4 * g + 1], b[2] + acc[4 * g + 2], b[3] + acc[4 * g + 3]};
            u32x2 w; w.x = cvt_pk_bf16(v[0], v[1]); w.y = cvt_pk_bf16(v[2], v[3]);
            *(u32x2*)(bo + 8 * g) = w;
            ss += (v[0] * v[0] + v[1] * v[1]) + (v[2] * v[2] + v[3] * v[3]);
        }
        ss = swap32_sum(ss);
        if (hi == 0) atomicAdd(ssq_out + SEQ + row, ss);
    }
};
struct SkLogit {
    const float* ssq; const float* bfl; float* out; int layer, rowbase;
    __device__ __forceinline__ void operator()(const f32x16& acc, int n0, int row, int r32, int hi) const {
        const int R = rowbase + row;
        const float rs = rsqrtf(ssq[R] * (1.0f / DM) + EPS);
        float* dst = (R < SEQ) ? out + O_PLOGF + ((size_t)layer * SEQ + R) * 6 : out + O_SLOGF + ((size_t)layer * NSMP + (R - SEQ)) * 6;
#pragma unroll
        for (int i = 0; i < 4; ++i) { const int col = 4 * hi + i;
            if (col < NH) { const float f = acc[i] * rs + bfl[col]; dst[col] = fminf(f, 0.f) - log1pf(expf(-fabsf(f))); } }
    }
};
template <int KSPLIT, class Epi, int WROWS = 32> __device__ __forceinline__ void skinny_item(LAS unsigned char* lds, const bf16_t* X, int ldx, const bf16_t* Wt, int ldw, int K, int n0, int rh, const Epi& E) {
    int tid = threadIdx.x; asm volatile("" : "+v"(tid));
    const int lane = tid & 63, r32 = lane & 31, hi = lane >> 5; const int wid = __builtin_amdgcn_readfirstlane(tid >> 6);
    constexpr int RW = 8 / KSPLIT;
    const int kh = wid / RW;
    const int row0 = 32 * RW * rh + 32 * (wid % RW);
    const int Kw = K / KSPLIT, kbeg = kh * Kw;
    LAS unsigned char* Xl = lds + wid * 16384; LAS unsigned char* Wl = Xl + 8192;
    const int lrow = lane >> 4, lch = lane & 15;
    const char* xg = (const char*)(X + kbeg); const char* wg = (const char*)(Wt + (size_t)n0 * ldw + kbeg);
    const unsigned xo = (unsigned)((row0 + lrow) * ldx + lch * 8) * 2u, wo = (unsigned)(lrow * ldw + lch * 8) * 2u;
    const unsigned xstep = (unsigned)ldx * 8u, wstep = (unsigned)ldw * 8u;
    f32x16 acc = f32x16{};
    bf16x8 xs[8], ws[8];
#define SK_LOAD(k0) do { _Pragma("unroll") for (int i_ = 0; i_ < 8; ++i_) { xs[i_] = *(const bf16x8*)(xg + (xo + i_ * xstep + (unsigned)(k0) * 2u)); if (i_ < WROWS / 4) ws[i_] = *(const bf16x8*)(wg + (wo + i_ * wstep + (unsigned)(k0) * 2u)); } } while (0)
    const int swz = (r32 & 7) << 4;
    const int offe = lrow * 256 + ((lch * 16) ^ (lrow << 4)), offo = lrow * 256 + ((lch * 16) ^ ((lrow + 4) << 4));
    SK_LOAD(0);
    if constexpr (WROWS < 32) {
#pragma unroll
        for (int j = WROWS / 4; j < 8; ++j) *(LAS u32x4*)(Wl + j * 1024 + lane * 16) = (u32x4){0u, 0u, 0u, 0u};
    }
    for (int k0 = 0; k0 < Kw; k0 += 128) {
#pragma unroll
        for (int i = 0; i < 8; ++i) { const int off = ((i & 1) ? offo : offe) + i * 1024; *(LAS bf16x8*)(Xl + off) = xs[i]; if (i < WROWS / 4) *(LAS bf16x8*)(Wl + off) = ws[i]; }
        if (k0 + 128 < Kw) SK_LOAD(k0 + 128);
#pragma unroll
        for (int d = 0; d < 4; ++d) { const int ka = r32 * 256 + ((d * 32 + hi * 16) ^ swz);
#pragma unroll
            for (int dh = 0; dh < 2; ++dh) {
                const bf16x8 xf = *(const LAS bf16x8*)(Xl + ka + dh * 128);
                const bf16x8 wf = *(const LAS bf16x8*)(Wl + ka + dh * 128);
                acc = __builtin_amdgcn_mfma_f32_32x32x16_bf16(wf, xf, acc, 0, 0, 0); } }
    }
#undef SK_LOAD
    if constexpr (KSPLIT > 1) {
        if (kh > 0) {
#pragma unroll
            for (int g = 0; g < 4; ++g) *(LAS f32x4*)(Xl + lane * 64 + g * 16) = (f32x4){acc[4 * g], acc[4 * g + 1], acc[4 * g + 2], acc[4 * g + 3]};
        }
        __syncthreads();
        if (kh == 0) {
#pragma unroll
            for (int p = 1; p < KSPLIT; ++p) { const LAS unsigned char* Pl = lds + (wid + p * RW) * 16384;
#pragma unroll
                for (int g = 0; g < 4; ++g) { const f32x4 q = *(const LAS f32x4*)(Pl + lane * 64 + g * 16); acc[4 * g] += q[0]; acc[4 * g + 1] += q[1]; acc[4 * g + 2] += q[2]; acc[4 * g + 3] += q[3]; } }
            E(acc, n0, row0 + r32, r32, hi);
        }
        __syncthreads();
    } else {
        E(acc, n0, row0 + r32, r32, hi);
    }
}

template <class Epi> __device__ __forceinline__ void skinny128_item(LAS unsigned char* lds, const bf16_t* X, int ldx, const bf16_t* Wt, int ldw, int K, int n0, int rh, const Epi& E) {
    int tid = threadIdx.x; asm volatile("" : "+v"(tid));
    const int lane = tid & 63, r32 = lane & 31, hi = lane >> 5; const int wid = __builtin_amdgcn_readfirstlane(tid >> 6);
    const int wrow = wid >> 1, wcol = wid & 1;
    const int lrow = lane >> 4, lch = lane & 15;
    const char* xg = (const char*)(X + (size_t)(128 * rh + 16 * wid) * ldx); const char* wg = (const char*)(Wt + (size_t)(n0 + 16 * wid) * ldw);
    const unsigned xoe = (unsigned)(lrow * ldx + (lch ^ lrow) * 8) * 2u, xoo = (unsigned)((lrow + 4) * ldx + (lch ^ (lrow + 4)) * 8) * 2u;
    const unsigned woe = (unsigned)(lrow * ldw + (lch ^ lrow) * 8) * 2u, woo = (unsigned)((lrow + 4) * ldw + (lch ^ (lrow + 4)) * 8) * 2u;
    const size_t x8 = (size_t)ldx * 16, w8 = (size_t)ldw * 16;
#define SK128_STAGE(t, b) do { LAS unsigned char* xl_ = lds + (b) * 65536 + wid * 4096; LAS unsigned char* wl_ = xl_ + 32768; const char* xs_ = xg + (size_t)(t) * 256; const char* ws_ = wg + (size_t)(t) * 256; \
        __builtin_amdgcn_global_load_lds((const unsigned*)(xs_ + xoe), (LAS unsigned*)(xl_), 16, 0, 0);             __builtin_amdgcn_global_load_lds((const unsigned*)(xs_ + xoo), (LAS unsigned*)(xl_ + 1024), 16, 0, 0); \
        __builtin_amdgcn_global_load_lds((const unsigned*)(xs_ + x8 + xoe), (LAS unsigned*)(xl_ + 2048), 16, 0, 0); __builtin_amdgcn_global_load_lds((const unsigned*)(xs_ + x8 + xoo), (LAS unsigned*)(xl_ + 3072), 16, 0, 0); \
        __builtin_amdgcn_global_load_lds((const unsigned*)(ws_ + woe), (LAS unsigned*)(wl_), 16, 0, 0);             __builtin_amdgcn_global_load_lds((const unsigned*)(ws_ + woo), (LAS unsigned*)(wl_ + 1024), 16, 0, 0); \
        __builtin_amdgcn_global_load_lds((const unsigned*)(ws_ + w8 + woe), (LAS unsigned*)(wl_ + 2048), 16, 0, 0); __builtin_amdgcn_global_load_lds((const unsigned*)(ws_ + w8 + woo), (LAS unsigned*)(wl_ + 3072), 16, 0, 0); } while (0)
    f32x16 acc0 = f32x16{}, acc1 = f32x16{};
    const int nst = K / 128;
    const int swz = (r32 & 7) << 4;
    SK128_STAGE(0, 0);
    for (int t = 0; t < nst; ++t) {
        VM_WAIT(); __syncthreads();
        if (t + 1 < nst) SK128_STAGE(t + 1, (t + 1) & 1);
        const LAS unsigned char* Xl = lds + (t & 1) * 65536 + wrow * 8192; const LAS unsigned char* Wl = lds + (t & 1) * 65536 + 32768 + wcol * 16384;
#pragma unroll
        for (int d = 0; d < 4; ++d) { const int ka = r32 * 256 + ((d * 32 + hi * 16) ^ swz);
#pragma unroll
            for (int dh = 0; dh < 2; ++dh) {
                const bf16x8 xf = *(const LAS bf16x8*)(Xl + ka + dh * 128);
                const bf16x8 w0 = *(const LAS bf16x8*)(Wl + ka + dh * 128), w1 = *(const LAS bf16x8*)(Wl + 8192 + ka + dh * 128);
                acc0 = __builtin_amdgcn_mfma_f32_32x32x16_bf16(w0, xf, acc0, 0, 0, 0);
                acc1 = __builtin_amdgcn_mfma_f32_32x32x16_bf16(w1, xf, acc1, 0, 0, 0); } }
    }
#undef SK128_STAGE
    E(acc0, n0 + 64 * wcol, 128 * rh + 32 * wrow + r32, r32, hi);
    E(acc1, n0 + 64 * wcol + 32, 128 * rh + 32 * wrow + r32, r32, hi);
    __syncthreads();
}

struct TrItem { const float* src; int ldw; const float* g; bf16_t* dst; int K; };
__device__ __forceinline__ void tr_load(const TrItem& t, f32x2 (&v)[16], int lane) {
    const int kq = lane >> 4, nn = (lane & 15) * 2;
#pragma unroll
    for (int i = 0; i < 16; ++i) v[i] = __builtin_nontemporal_load((const f32x2*)(t.src + (size_t)(4 * i + kq) * t.ldw + nn));
}
__device__ __forceinline__ void tr_process(const TrItem& t, const f32x2 (&v)[16], LAS float* scr, int lane) {
    const int kq = lane >> 4, nn = (lane & 15) * 2;
#pragma unroll
    for (int i = 0; i < 16; ++i) { scr[(4 * i + kq) * 33 + nn] = v[i].x; scr[(4 * i + kq) * 33 + nn + 1] = v[i].y; }
    LDS_WAIT(); asm volatile("" ::: "memory");
    const int c = lane & 7;
    float gv[8];
    if (t.g) { const f32x4 a = *(const f32x4*)(t.g + 8 * c), b = *(const f32x4*)(t.g + 8 * c + 4);
#pragma unroll
        for (int i = 0; i < 4; ++i) { gv[i] = a[i]; gv[4 + i] = b[i]; } }
    else {
#pragma unroll
        for (int i = 0; i < 8; ++i) gv[i] = 1.f; }
#pragma unroll
    for (int j = 0; j < 4; ++j) { const int n = (lane >> 3) + 8 * j; const LAS float* s = scr + (8 * c) * 33 + n;
        u32x4 o; o.x = cvt_pk_bf16(s[0 * 33] * gv[0], s[1 * 33] * gv[1]); o.y = cvt_pk_bf16(s[2 * 33] * gv[2], s[3 * 33] * gv[3]);
        o.z = cvt_pk_bf16(s[4 * 33] * gv[4], s[5 * 33] * gv[5]); o.w = cvt_pk_bf16(s[6 * 33] * gv[6], s[7 * 33] * gv[7]);
        *(u32x4*)(t.dst + (size_t)n * t.K + 8 * c) = o; }
    LDS_WAIT(); asm volatile("" ::: "memory");
}

struct TrCtx { const float *win, *wout, *wgate, *wup, *wdown, *n1g, *n2g; bf16_t *WIN, *WOUT, *WGU, *WDN; };
constexpr int TR_PD1 = 5376;
constexpr int TR_W1PB = 768;
constexpr int TR_IN = 32 * 192, TR_OUT = 32 * 64, TR_G = 32 * 176, TR_D = 88 * 64, TR_L = TR_IN + TR_OUT + 2 * TR_G + TR_D, TR_ALL = 2 * TR_L;
__device__ __forceinline__ void tr_kn(int r, int nblk, int& kb, int& nb) {
    const int B = r >> 3, w = r & 7, nq = nblk >> 2;
    kb = 2 * (B / nq) + (w >> 2); nb = 4 * (B % nq) + (w & 3);
}
__device__ __forceinline__ TrItem tr_decode(const TrCtx& c, int it) {
    const int l = it / TR_L; int r = it % TR_L; TrItem t; int kb, nb;
    if (r < TR_IN) { tr_kn(r, 192, kb, nb); t.src = c.win + ((size_t)l * DM + 64 * kb) * IN_DIM + 32 * nb; t.ldw = IN_DIM; t.g = c.n1g + l * DM + 64 * kb; t.dst = c.WIN + l * WIN_L + (size_t)(32 * nb) * DM + 64 * kb; t.K = DM; return t; }
    r -= TR_IN;
    if (r < TR_OUT) { tr_kn(r, 64, kb, nb); t.src = c.wout + ((size_t)l * DM + 64 * kb) * DM + 32 * nb; t.ldw = DM; t.g = nullptr; t.dst = c.WOUT + l * WOUT_L + (size_t)(32 * nb) * DM + 64 * kb; t.K = DM; return t; }
    r -= TR_OUT;
    if (r < 2 * TR_G) { const int up = r / TR_G; r %= TR_G; tr_kn(r, 176, kb, nb); const int n0 = 32 * nb;
        t.src = (up ? c.wup : c.wgate) + ((size_t)l * DM + 64 * kb) * DFF + n0; t.ldw = DFF; t.g = c.n2g + l * DM + 64 * kb;
        t.dst = c.WGU + l * WGU_L + (size_t)(256 * (n0 / 128) + 128 * up + (n0 % 128)) * DM + 64 * kb; t.K = DM; return t; }
    r -= 2 * TR_G;
    { tr_kn(r, 64, kb, nb); t.src = c.wdown + ((size_t)l * DFF + 64 * kb) * DM + 32 * nb; t.ldw = DM; t.g = nullptr; t.dst = c.WDN + l * WDN_L + (size_t)(32 * nb) * DFF + 64 * kb; t.K = DFF; return t; }
}
template <int N> __device__ __forceinline__ void tr_run(const TrCtx& c, int u0, LAS float* scr, int lane) {
    f32x2 va[16], vb[16];
    TrItem ta = tr_decode(c, u0), tb;
    tr_load(ta, va, lane);
#pragma unroll 1
    for (int uu = 0; uu < N; uu += 2) {
        tb = tr_decode(c, u0 + uu + 1); tr_load(tb, vb, lane);
        tr_process(ta, va, scr, lane);
        if (uu + 2 < N) { ta = tr_decode(c, u0 + uu + 2); tr_load(ta, va, lane); }
        tr_process(tb, vb, scr, lane);
    }
}
template <int NIT> __device__ __forceinline__ void knorm_items(const float* cfk, int it0, float* kpart, int lane) {
    const int half = lane >> 5, c4 = (lane & 31) * 4;
    f32x4 va[12], vb[12];
    float hm[6];
#define KN_LOAD(V, q) do { const int it_ = it0 + ((q) >> 2), pq_ = (q) & 3; const float* b_ = cfk + ((size_t)(it_ / (PAST / 16)) * PAST + (it_ % (PAST / 16)) * 16) * 768; \
        _Pragma("unroll") for (int u_ = 0; u_ < 2; ++u_) _Pragma("unroll") for (int h_ = 0; h_ < 6; ++h_) V[u_ * 6 + h_] = __builtin_nontemporal_load((const f32x4*)(b_ + (size_t)((2 * (2 * pq_ + u_) + half) * 6 + h_) * 128 + c4)); } while (0)
#define KN_REDUCE(V, q) do { if (((q) & 3) == 0) { _Pragma("unroll") for (int h_ = 0; h_ < 6; ++h_) hm[h_] = 0.f; } \
        _Pragma("unroll") for (int u_ = 0; u_ < 2; ++u_) _Pragma("unroll") for (int h_ = 0; h_ < 6; ++h_) { const f32x4 w_ = V[u_ * 6 + h_]; float ss_ = (w_[0] * w_[0] + w_[1] * w_[1]) + (w_[2] * w_[2] + w_[3] * w_[3]); \
            ss_ = swap16_sum(row16_sum(ss_)); hm[h_] = fmaxf(hm[h_], ss_); } \
        if (((q) & 3) == 3) { const int it_ = it0 + ((q) >> 2), lb_ = it_ / (PAST / 16); \
            _Pragma("unroll") for (int h_ = 0; h_ < 6; ++h_) { const float mx_ = swap32_max(hm[h_]); if (lane == 0) kpart[(size_t)(lb_ * NH + h_) * (PAST / 16) + (it_ % (PAST / 16))] = mx_; } } } while (0)
    KN_LOAD(va, 0);
#pragma unroll 1
    for (int q = 0; q < 4 * NIT; q += 2) {
        KN_LOAD(vb, q + 1);
        KN_REDUCE(va, q);
        if (q + 2 < 4 * NIT) KN_LOAD(va, q + 2);
        KN_REDUCE(vb, q + 1);
    }
#undef KN_LOAD
#undef KN_REDUCE
}

#ifndef PB_MASK
#define PB_MASK 31
#endif
#ifndef TIMING
#define TIMING 0
#define TIMING_BX 0
#endif
#define STAMP2(i) do { int t_ = threadIdx.x; asm volatile("" : "+v"(t_)); if (TIMING == 2 && bx == TIMING_BX && t_ == 0) MISC[16 + (i)] = (unsigned)__builtin_amdgcn_s_memrealtime(); } while (0)
#define STAMP3(i) do { int t_ = threadIdx.x; asm volatile("" : "+v"(t_)); if (TIMING == 3 && bx == TIMING_BX && t_ == 0) MISC[16 + (i)] = (unsigned)__builtin_amdgcn_s_memrealtime(); } while (0)
#define STAMP(i) do { int t_ = threadIdx.x; asm volatile("" : "+v"(t_)); if ((TIMING == 1 || TIMING == 3) && bx == TIMING_BX && t_ == 0) MISC[16 + (i)] = (unsigned)__builtin_amdgcn_s_memrealtime(); } while (0)
#ifndef STOP_AFTER
#define STOP_AFTER 99
#endif
struct Params { const float* in[18]; float* out; unsigned char* ws; };
enum { I_XP = 0, I_XS, I_SCONV, I_CSBK, I_CSBV, I_CFK, I_CFV, I_CLOGF, I_N1G, I_WIN, I_BF, I_CONVW, I_WOUT, I_N2G, I_WGATE, I_WUP, I_WDOWN, I_FG };

#define KARG(i) (*(const float* const volatile __attribute__((address_space(4)))*)((const __attribute__((address_space(4))) char*)__builtin_amdgcn_kernarg_segment_ptr() + 8 * (i)))
__global__ void __launch_bounds__(512, 2) hybrid_fwd(Params P) {
    extern __shared__ __attribute__((aligned(16))) unsigned char lds_raw[];
    LAS unsigned char* lds = (LAS unsigned char*)lds_raw;
    volatile LAS unsigned* MISC = (volatile LAS unsigned*)(lds + MISC_OFF);
    const int tid = threadIdx.x, lane = tid & 63; const int wave = __builtin_amdgcn_readfirstlane(tid >> 6);
    const int G = gridDim.x; const int bx = blockIdx.x; const int vcu = (G % 8 == 0) ? (bx % 8) * (G / 8) + bx / 8 : bx;
    const int gw = vcu * 8 + wave, NGW = G * 8;
    unsigned char* ws = P.ws;
    unsigned* ctl = (unsigned*)(ws + WS_CTL);
    float* out = P.out;
    bf16_t* WFB = (bf16_t*)(ws + WS_WF); float* KPART = (float*)(ws + WS_WF + 524288);
    bf16_t* WIN = (bf16_t*)(ws + WS_WIN); bf16_t* WOUT = (bf16_t*)(ws + WS_WOUT); bf16_t* WGU = (bf16_t*)(ws + WS_WGU); bf16_t* WDN = (bf16_t*)(ws + WS_WDN);
    bf16_t* XB = (bf16_t*)(ws + WS_XB); bf16_t* PROJ = (bf16_t*)(ws + WS_PROJ); bf16_t* Y = (bf16_t*)(ws + WS_Y); bf16_t* H = (bf16_t*)(ws + WS_H);
    float* SSQ = (float*)(ctl + CW_SSQ);
    for (int u = tid; u < (LDS_BYTES - RING_BYTES) / 4; u += 512) ((LAS unsigned*)(lds + RING_BYTES))[u] = 0u;
    __syncthreads();
    XcdBarrier bar = xcd_barrier_post(ctl + CW_BAR, MISC + 8);
    STAMP(0); STAMP2(0);

    {
        LAS float* scr = (LAS float*)(lds + wave * 16384);
        constexpr int NITEMS = TR_IN;
        const TrCtx TC{P.in[I_WIN], P.in[I_WOUT], P.in[I_WGATE], P.in[I_WUP], P.in[I_WDOWN], P.in[I_N1G], P.in[I_N2G], WIN, WOUT, WGU, WDN};
        constexpr int N_ROWS = MT, N_KN = DB * (PAST / 16), Q_KN = N_KN / 8, Q_TR = NITEMS / 32, Q_ROW = N_ROWS / 32, Q_ALL = Q_KN + Q_TR + Q_ROW;
        volatile LAS unsigned* qidx0 = MISC + 12;
        for (;;) {
            if (tid == 0) qidx0[0] = __hip_atomic_fetch_add(ctl + CW_Q + 128, 1u, __ATOMIC_RELAXED, __HIP_MEMORY_SCOPE_AGENT);
            __syncthreads();
            const int qi = (int)qidx0[0];
            __syncthreads();
            if (qi >= Q_ALL) break;
            if (qi < Q_KN) { knorm_items<1>(P.in[I_CFK], qi * 8 + wave, KPART, lane); continue; }
            if (qi < Q_KN + Q_TR) { tr_run<4>(TC, ((qi - Q_KN) * 8 + wave) * 4, scr, lane); continue; }
            {
                const int r0 = ((qi - Q_KN - Q_TR) * 8 + wave) * 4;
                f32x4 xa[8], xb[8];
#define ROW_PTR(r) (((r) < SEQ) ? P.in[I_XP] + (size_t)(r) * DM : P.in[I_XS] + (size_t)((r) - SEQ) * DM)
#define ROW_LOAD(V, r) do { const float* xr_ = ROW_PTR(r); _Pragma("unroll") for (int i_ = 0; i_ < 4; ++i_) { V[2 * i_] = __builtin_nontemporal_load((const f32x4*)(xr_ + 8 * lane + 512 * i_)); V[2 * i_ + 1] = __builtin_nontemporal_load((const f32x4*)(xr_ + 8 * lane + 512 * i_ + 4)); } } while (0)
#define ROW_DONE(V, r) do { float s_ = 0.f; _Pragma("unroll") for (int i_ = 0; i_ < 4; ++i_) { const f32x4 a_ = V[2 * i_], b_ = V[2 * i_ + 1]; \
        s_ += (a_[0] * a_[0] + a_[1] * a_[1]) + (a_[2] * a_[2] + a_[3] * a_[3]) + (b_[0] * b_[0] + b_[1] * b_[1]) + (b_[2] * b_[2] + b_[3] * b_[3]); \
        u32x4 w_; w_.x = cvt_pk_bf16(a_[0], a_[1]); w_.y = cvt_pk_bf16(a_[2], a_[3]); w_.z = cvt_pk_bf16(b_[0], b_[1]); w_.w = cvt_pk_bf16(b_[2], b_[3]); \
        *(u32x4*)(XB + (size_t)(r) * DM + 8 * lane + 512 * i_) = w_; } \
        s_ = wave_sum(s_); if (lane == 0) SSQ[(r)] = s_; } while (0)
                ROW_LOAD(xa, r0);
#pragma unroll 1
                for (int uu = 0; uu < 4; uu += 2) {
                    ROW_LOAD(xb, r0 + uu + 1);
                    ROW_DONE(xa, r0 + uu);
                    if (uu + 2 < 4) ROW_LOAD(xa, r0 + uu + 2);
                    ROW_DONE(xb, r0 + uu + 1);
                }
#undef ROW_PTR
#undef ROW_LOAD
#undef ROW_DONE
            }
        }
        STAMP2(2);
        for (int e = vcu * 512 + tid; e < 2 * 32 * DM; e += G * 512) {
            const int l = e / (32 * DM), j = (e % (32 * DM)) / DM, k = e % DM;
            const float v = (j < NH) ? P.in[I_N1G][l * DM + k] * P.in[I_WIN][((size_t)l * DM + k) * IN_DIM + NPROJ + j] : 0.f;
            WFB[e] = (bf16_t)(cvt_pk_bf16(v, 0.f) & 0xffffu);
        }
        STAMP2(3);
    }
    STAMP2(4);
    xcd_barrier(bar);
    STAMP(1); STAMP2(5);

    for (int l = 0; l < 2; ++l) {
        int tid = threadIdx.x; asm volatile("" : "+v"(tid)); const int lane = tid & 63; const int gw = vcu * 8 + __builtin_amdgcn_readfirstlane(tid >> 6);
        long zoff = 0; asm volatile("" : "+s"(zoff));
        unsigned char* ws = P.ws + zoff; float* out = P.out + zoff;
        unsigned* ctl = (unsigned*)(ws + WS_CTL);
        bf16_t* WFB = (bf16_t*)(ws + WS_WF); float* KPART = (float*)(ws + WS_WF + 524288);
        bf16_t* WIN = (bf16_t*)(ws + WS_WIN); bf16_t* WOUT = (bf16_t*)(ws + WS_WOUT); bf16_t* WGU = (bf16_t*)(ws + WS_WGU); bf16_t* WDN = (bf16_t*)(ws + WS_WDN);
        bf16_t* XB = (bf16_t*)(ws + WS_XB); bf16_t* PROJ = (bf16_t*)(ws + WS_PROJ); bf16_t* Y = (bf16_t*)(ws + WS_Y); bf16_t* H = (bf16_t*)(ws + WS_H);
        float* SSQ = (float*)(ctl + CW_SSQ);
        const float* ssq_in = SSQ + (size_t)(2 * l) * MT;
        float* ssq_mid = SSQ + (size_t)(2 * l + 1) * MT;
        float* ssq_next = SSQ + (size_t)(2 * l + 2) * MT;
        {
            if (l == 0) STAMP2(6);
            const SkProj SE{PROJ, ssq_in, out, l, ctl + CW_KMAXS};
            constexpr int NSK = 2 * (NPROJ / 128), NLG = 4 * (MT / 256);
            int si0, si1, sis, lq0, lq1, lqs;
            if (G == 256) { const int x = (bx & 7) >> 1, i = bx >> 3, hr = (bx >> 3) * 4 + ((bx & 7) >> 1);
                const bool lightw = !(bx & 1);
                si0 = (lightw && i < 24) ? x * 24 + i : NSK; si1 = NSK; sis = 1 << 20;
                lq0 = lightw ? (i >= 24 ? 128 + x * 8 + (i - 24) : NLG) : hr; lq1 = NLG; lqs = 1 << 20;
            } else { si0 = bx; si1 = NSK; sis = G; lq0 = bx; lq1 = NLG; lqs = G; }
            for (int i = si0; i < si1; i += sis) skinny128_item(lds, XB + (size_t)SEQ * DM, DM, WIN + l * WIN_L, DM, DM, 128 * (i >> 1), i & 1, SE);
            const bool lg_first = (G == 256) && ((bx >> 3) & 1);
            if (lg_first) for (int q = lq0; q < lq1; q += lqs) {
                const SkLogit LE{ssq_in, KARG(I_BF) + l * NH, out, l, 256 * (q >> 2)};
                skinny_item<4, SkLogit, 8>(lds, XB + (size_t)(q >> 2) * 256 * DM, DM, WFB + (size_t)l * 32 * DM, DM, DM, 0, q & 3, LE);
            }
            if (l == 0) STAMP2(7);
            pg8::Gemm g{XB, WIN + l * WIN_L, SEQ, NPROJ, DM}; pg8::StaticOrder S; S.init(SEQ, NPROJ, G, bx, 1);
            pg8::EpiProj E{PROJ, ssq_in, out, l, ctl + CW_KMAXP};
            pg8::gemm_phase<pg8::EpiProj, pg8::StaticOrder, true, true>(lds, g, S, E);
            if (l == 0) STAMP(2);
            if (!lg_first) for (int q = lq0; q < lq1; q += lqs) {
                const SkLogit LE{ssq_in, KARG(I_BF) + l * NH, out, l, 256 * (q >> 2)};
                skinny_item<4, SkLogit, 8>(lds, XB + (size_t)(q >> 2) * 256 * DM, DM, WFB + (size_t)l * 32 * DM, DM, DM, 0, q & 3, LE);
            }
        }
        if (l == 0) STAMP2(8);
        xcd_barrier(bar);
        STAMP(l == 0 ? 3 : 10); if (l == 0) STAMP2(9);
        if (STOP_AFTER == 1 + 5 * l) return;
        {
            constexpr int NHP = NH / 2, N_PA = 2 * 64 * NHP, N_SA = 2 * DB * NHP, N_CV = MT / 64, N_ALL = N_PA + N_SA + N_CV;
            const int n_a = N_ALL + (l == 0 ? DB * (PAST / 16) / 8 : 0);
            const bool win1_in_pd = (G == 256);
            const int cv_first = (l == 0) ? TR_IN : TR_L + TR_IN, n_b = ((l == 0) ? (win1_in_pd ? TR_L - TR_IN + TR_W1PB : TR_L) : TR_L - TR_IN - (win1_in_pd ? TR_PD1 : 0)) / 32;
            const int n_min = n_a < n_b ? n_a : n_b, n_items = n_a + n_b;
            const TrCtx TC{KARG(I_WIN), KARG(I_WOUT), KARG(I_WGATE), KARG(I_WUP), KARG(I_WDOWN), KARG(I_N1G), KARG(I_N2G), WIN, WOUT, WGU, WDN};
            volatile LAS unsigned* qidx = MISC + 12;
            for (;;) {
                if (tid == 0) qidx[0] = __hip_atomic_fetch_add(ctl + CW_Q + 64 * l, 1u, __ATOMIC_RELAXED, __HIP_MEMORY_SCOPE_AGENT);
                __syncthreads();
                const int qi = (int)qidx[0];
                __syncthreads();
                if (qi >= n_items) break;
                int idx, cvi = -1;
                if (qi < 2 * n_min) { if (qi & 1) cvi = qi >> 1; idx = qi >> 1; } else if (n_a > n_b) idx = qi - n_min; else { cvi = qi - n_min; idx = 0; }
                if (cvi >= 0) { tr_run<4>(TC, cv_first + (cvi * 8 + __builtin_amdgcn_readfirstlane(tid >> 6)) * 4, (LAS float*)(lds + __builtin_amdgcn_readfirstlane(tid >> 6) * 16384), lane); continue; }
                {
                    const int n_kn = n_a - N_ALL, ia = idx - (N_PA + N_SA);
                    if (ia >= 0 && ia < n_kn) { knorm_items<1>(KARG(I_CFK), DB * (PAST / 16) + ia * 8 + __builtin_amdgcn_readfirstlane(tid >> 6), KPART, lane); continue; }
                    if (ia >= n_kn) idx -= n_kn;
                }
                if (idx < N_PA + N_SA) {
                    AttnItem it;
                    int type, h, b = 0;
                    if (idx >= N_SA) { const int ip = idx - N_SA; type = ip / (64 * NHP); const int rem = ip % (64 * NHP); const int qt = 63 - rem / NHP; h = 2 * (rem % NHP);
                        it.nq = 128; it.t0 = 128 * qt; it.Kc = 0; it.Knew_cnt = SEQ;
                        it.Q = PROJ + (size_t)it.t0 * NPROJ; it.Knew = PROJ; it.Vnew = PROJ; it.Kcache = nullptr; it.Vcache = nullptr; it.Lcache = nullptr;
                        it.Lnew = out + O_PLOGF + (size_t)l * SEQ * 6 + h; it.O = Y + (size_t)it.t0 * DM;
                        const unsigned* km = ctl + CW_KMAXP + (l * NH + h) * 4;
                        it.kn2 = (__uint_as_float(km[0]) + __uint_as_float(km[1])) + (__uint_as_float(km[2]) + __uint_as_float(km[3]));
                        it.kn2b = (__uint_as_float(km[4]) + __uint_as_float(km[5])) + (__uint_as_float(km[6]) + __uint_as_float(km[7]));
                    } else { const int k = idx; type = k / (DB * NHP); b = (k % (DB * NHP)) / NHP; h = 2 * (k % NHP);
                        it.nq = DSEQ; it.t0 = PAST; it.Kc = PAST; it.Knew_cnt = DSEQ;
                        const size_t row0 = (size_t)SEQ + DSEQ * b;
                        it.Q = PROJ + row0 * NPROJ; it.Knew = PROJ + row0 * NPROJ; it.Vnew = PROJ + row0 * NPROJ;
                        const size_t coff = ((size_t)(l * DB + b) * PAST) * 768 + h * HD;
                        it.Kcache = P.in[type == 0 ? I_CSBK : I_CFK] + coff; it.Vcache = P.in[type == 0 ? I_CSBV : I_CFV] + coff;
                        it.Lcache = KARG(I_CLOGF) + ((size_t)(l * DB + b) * PAST) * 6 + h;
                        it.Lnew = out + O_SLOGF + ((size_t)l * NSMP + DSEQ * b) * 6 + h; it.O = Y + row0 * DM;
                        const unsigned* km = ctl + CW_KMAXS + ((l * DB + b) * NH + h) * 4;
                        const float kn_new = (__uint_as_float(km[0]) + __uint_as_float(km[1])) + (__uint_as_float(km[2]) + __uint_as_float(km[3]));
                        const float kn_newb = (__uint_as_float(km[4]) + __uint_as_float(km[5])) + (__uint_as_float(km[6]) + __uint_as_float(km[7]));
                        float kc = KPART[(size_t)((l * DB + b) * NH + h + (tid >> 8)) * (PAST / 16) + (tid & 255)];
                        kc = swap32_max(fmaxf(row16_max(kc), 0.f)); { auto rr = __builtin_amdgcn_permlane16_swap(__float_as_uint(kc), __float_as_uint(kc), false, false); kc = fmaxf(__uint_as_float(rr[0]), __uint_as_float(rr[1])); }
                        volatile LAS float* kred = (volatile LAS float*)(lds + AL_FLAG + 128);
                        if (lane == 0) kred[tid >> 6] = kc;
                        __syncthreads();
                        it.kn2 = fmaxf(kn_new, fmaxf(fmaxf(kred[0], kred[1]), fmaxf(kred[2], kred[3])));
                        it.kn2b = fmaxf(kn_newb, fmaxf(fmaxf(kred[4], kred[5]), fmaxf(kred[6], kred[7])));
                    }
                    it.sb = (type == 0);
                    const int cq_ = (type == 0 ? C_SQ : C_FQ) + h * HD, ck_ = (type == 0 ? C_SK : C_FK) + h * HD, cv_ = (type == 0 ? C_SV : C_FV) + h * HD;
                    it.Q += cq_; it.Knew += ck_; it.Vnew += cv_; it.O += (type == 0 ? CONVD : CONVD + NH * HD) + h * HD;
                    const int pbit = (idx >= N_SA ? 1 : 4) << (type == 0 ? 0 : 1);
                    if (PB_MASK & pbit) { if (type == 0) attn_item<1>(it, lds); else attn_item<0>(it, lds); }
                } else {
                    if (PB_MASK & 16) conv_item(idx - (N_PA + N_SA), l, PROJ, Y, KARG(I_SCONV), KARG(I_CONVW), out);
                }
            }
        }
        xcd_barrier(bar);
        STAMP(l == 0 ? 4 : 11); if (l == 0) STAMP2(10);
        if (STOP_AFTER == 2 + 5 * l) {
            for (size_t e = (size_t)bx * 512 + tid; e < (size_t)SEQ * DM; e += (size_t)G * 512) out[O_YP + e] = bf_lo((unsigned)Y[e]);
            return; }
        {
            pg8::Gemm g{Y, WOUT + l * WOUT_L, SEQ, DM, DM}; pg8::StaticOrder S; S.init(SEQ, DM, G, bx);
            const int nsk = 4 * (DM / 32);
            const bool sk_first = (G == 256) && ((bx >> 3) & 1);
            {
                pg8::EpiRes<false> E{nullptr, XB, ssq_mid};
                const SkRes<false> SE{nullptr, XB, ssq_mid};
#pragma unroll 1
                for (int step = 0; step < 2; ++step) {
                    if ((step == 0) == sk_first) { for (int i = bx; i < nsk; i += G) skinny_item<4>(lds, Y + (size_t)SEQ * DM, DM, WOUT + l * WOUT_L, DM, DM, 32 * (i >> 2), i & 3, SE); }
                    else { pg8::gemm_phase<pg8::EpiRes<false>, pg8::StaticOrder, true, true>(lds, g, S, E); if (l == 0) { STAMP(5); STAMP2(11); } }
                }
            }
        }
        if (l == 0) STAMP2(12);
        xcd_barrier(bar);
        STAMP(l == 0 ? 6 : 12); if (l == 0) STAMP2(13);
        if (STOP_AFTER == 3 + 5 * l) {
            for (size_t e = (size_t)bx * 512 + tid; e < (size_t)SEQ * DM; e += (size_t)G * 512) out[O_YP + e] = bf_lo((unsigned)XB[e]);
            return; }
        {
            pg8::Gemm g{XB, WGU + l * WGU_L, MT, NGU, DM}; pg8::StaticOrder S; S.init(MT, NGU, G, bx);
            pg8::EpiGU E{H, ssq_mid};
            pg8::gemm_phase<pg8::EpiGU, pg8::StaticOrder, true, true>(lds, g, S, E);
            constexpr int N_PD = (MT / 256) * (NGU / 256), N_LAST = N_PD % 256;
            if (l == 1 && G == 256 && bx >= N_LAST) {
                const TrCtx TC{KARG(I_WIN), KARG(I_WOUT), KARG(I_WGATE), KARG(I_WUP), KARG(I_WDOWN), KARG(I_N1G), KARG(I_N2G), WIN, WOUT, WGU, WDN};
                int tc = threadIdx.x; asm volatile("" : "+v"(tc));
                const int lane = tc & 63; const int wv = __builtin_amdgcn_readfirstlane(tc >> 6);
                for (int u = 2 * TR_L - TR_PD1 + ((bx - N_LAST) * 8 + wv) * 4; u < 2 * TR_L; u += (256 - N_LAST) * 8 * 4) tr_run<4>(TC, u, (LAS float*)(lds + wv * 16384), lane);
            }
            if (l == 0 && G == 256 && bx >= N_LAST) {
                const TrCtx TC{KARG(I_WIN), KARG(I_WOUT), KARG(I_WGATE), KARG(I_WUP), KARG(I_WDOWN), KARG(I_N1G), KARG(I_N2G), WIN, WOUT, WGU, WDN};
                int tc0 = threadIdx.x; asm volatile("" : "+v"(tc0));
                const int lane = tc0 & 63; const int wv = __builtin_amdgcn_readfirstlane(tc0 >> 6);
                for (int u = TR_L + TR_W1PB + ((bx - N_LAST) * 8 + wv) * 4; u < TR_L + TR_IN; u += (256 - N_LAST) * 8 * 4) tr_run<4>(TC, u, (LAS float*)(lds + wv * 16384), lane);
            }
        }
        xcd_barrier(bar);
        if (TIMING == 3) { if (l == 0) STAMP3(7); } else STAMP(l == 0 ? 7 : 13); if (l == 0) STAMP2(14);
        if (STOP_AFTER == 4 + 5 * l) {
            for (size_t e = (size_t)bx * 512 + tid; e < (size_t)SEQ * DM; e += (size_t)G * 512) out[O_YP + e] = bf_lo((unsigned)H[(e / DM) * DFF + (e % DM)]);
            return; }
        {
            pg8::Gemm g{H, WDN + l * WDN_L, SEQ, DM, DFF}; pg8::StaticOrder S; S.init(SEQ, DM, G, bx);
            pg8::EpiRes<false> E{nullptr, XB, ssq_next};
            const SkRes<false> SE{nullptr, XB, ssq_next};
            const bool sk_first = (G == 256) && ((bx >> 3) & 1);
#pragma unroll 1
            for (int step = 0; step < 2; ++step) {
                if ((step == 0) == sk_first) { for (int i = bx; i < 4 * (DM / 32); i += G) skinny_item<4>(lds, H + (size_t)SEQ * DFF, DFF, WDN + l * WDN_L, DFF, DFF, 32 * (i >> 2), i & 3, SE); }
                else { pg8::gemm_phase<pg8::EpiRes<false>, pg8::StaticOrder, true, true>(lds, g, S, E); if (l == 0) STAMP(8); }
            }
        }
        xcd_barrier(bar);
        if (TIMING == 3) STAMP3(l == 0 ? 9 : 13); else STAMP(l == 0 ? 9 : 14);
        if (STOP_AFTER == 5 + 5 * l) {
            for (size_t e = (size_t)bx * 512 + tid; e < (size_t)SEQ * DM; e += (size_t)G * 512) out[O_YP + e] = bf_lo((unsigned)XB[e]);
            return; }
    }
    {
        int tid_f = threadIdx.x; asm volatile("" : "+v"(tid_f));
        const int lane = tid_f & 63; const int gw = vcu * 8 + __builtin_amdgcn_readfirstlane(tid_f >> 6);
        const float* ssq_f = SSQ + (size_t)4 * MT; const float* fg = KARG(I_FG);
        const unsigned tmo = __hip_atomic_load(ctl + CW_BAR + XB_TMO, __ATOMIC_RELAXED, __HIP_MEMORY_SCOPE_AGENT);
        const int n_main = SEQ / NGW + ((gw < SEQ % NGW) ? 1 : 0), n_all = n_main + ((__builtin_amdgcn_readfirstlane(tid_f >> 6) == 0) ? (NSMP - vcu + G - 1) / G : 0);
        for (int q = 0; q < n_all; ++q) {
            const int r = (q < n_main) ? gw + q * NGW : SEQ + vcu + (q - n_main) * G;
            float rs = rsqrtf(ssq_f[r] * (1.0f / DM) + EPS);
            if (tmo) rs = __builtin_nanf("");
            const bf16_t* xr = XB + (size_t)r * DM; float* yo = (r < SEQ) ? out + O_YP + (size_t)r * DM : out + O_YS + (size_t)(r - SEQ) * DM;
#pragma unroll
            for (int i = 0; i < 8; ++i) { const u32x2 w = *(const u32x2*)(xr + 4 * lane + 256 * i); const f32x4 x = {bf_lo(w.x), bf_hi(w.x), bf_lo(w.y), bf_hi(w.y)}, gq = *(const f32x4*)(fg + 4 * lane + 256 * i);
                __builtin_nontemporal_store(x * rs * gq, (f32x4*)(yo + 4 * lane + 256 * i)); }
        }
    }
    if (TIMING) {
        STAMP(15); STAMP3(14);
        xcd_barrier(bar);
        if (bx == TIMING_BX) {
            const size_t offs[15] = {O_YP, O_YS, O_PCONV, O_PSBK, O_PSBV, O_PFK, O_PFV, O_PLOGF, O_SCONV, O_SSBK, O_SSBV, O_SFK, O_SFV, O_SLOGF, O_TOTAL};
#pragma unroll 1
            for (int k = 0; k < 14; ++k) {
                unsigned n = MISC[16 + k + 1] - MISC[16 + k]; n = (n + 5u) / 10u;
                size_t cap = offs[k + 1] - offs[k]; if (cap > 60000) cap = 60000; if (n > cap) n = (unsigned)cap;
                for (unsigned e = tid; e < (unsigned)cap; e += 512) ((unsigned*)out)[offs[k] + e] = (e < n) ? 0xAAAAAAAAu : 0u;
            }
        }
    }
}

extern "C" void kernel_launch(void* const* d_in, const int* in_sizes, int n_in, void* d_out, int out_size, void* d_ws, size_t ws_size, hipStream_t stream) {
    static int grid = 0;
    if (grid == 0) {
        if (n_in != 18 || (size_t)out_size != O_TOTAL || ws_size < WS_END) { fprintf(stderr, "kernel_launch: unexpected shapes (n_in %d out %d ws %zu)\n", n_in, out_size, ws_size); grid = -1; return; }
        int dev = 0, cus = 0, per_cu = 0;
        if (hipGetDevice(&dev) != hipSuccess || hipDeviceGetAttribute(&cus, hipDeviceAttributeMultiprocessorCount, dev) != hipSuccess) { grid = -1; return; }
        if (hipFuncSetAttribute((const void*)hybrid_fwd, hipFuncAttributeMaxDynamicSharedMemorySize, LDS_BYTES) != hipSuccess) { fprintf(stderr, "kernel_launch: hipFuncSetAttribute failed\n"); grid = -1; return; }
        if (hipOccupancyMaxActiveBlocksPerMultiprocessor(&per_cu, (const void*)hybrid_fwd, 512, LDS_BYTES) != hipSuccess || per_cu < 1) { fprintf(stderr, "kernel_launch: occupancy query says %d\n", per_cu); }
        (void)hipGetLastError();
        grid = cus;
    }
    if (grid < 0) return;
    if (hipMemsetAsync((char*)d_ws + WS_CTL, 0, CTL_ZERO_BYTES, stream) != hipSuccess) return;
    Params p{};
    for (int i = 0; i < 18; ++i) p.in[i] = (const float*)d_in[i];
    p.out = (float*)d_out; p.ws = (unsigned char*)d_ws;
    hipLaunchKernelGGL(hybrid_fwd, dim3(grid), dim3(512), LDS_BYTES, stream, p);
}
```
